# Optimizing an MI355X kernel written in HIP

```python
import jax, jax.numpy as jnp
from jax import lax
import numpy as np


D_MODEL = 1024
BATCH = 4
SEQ = 4096
DEPTH = 1

EPS = 1e-6
D_FF = 2816
FFN_RES_WEIGHT = 0.5
CONV_DIM = D_MODEL
CONV_K = 3
GLA_HEADS = 4
GLA_DK = D_MODEL // 2 // GLA_HEADS
GLA_DV = D_MODEL // GLA_HEADS
GLA_QK = GLA_HEADS * GLA_DK
GLA_V = GLA_HEADS * GLA_DV
GATE_RANK = 16
GATE_TAU = 16.0
CHUNK = 64
IN_SIZES = (CONV_DIM, CONV_DIM, CONV_DIM, GLA_QK, GLA_QK, GLA_V, GATE_RANK, GLA_V, D_MODEL, D_MODEL)
IN_COLS = sum(IN_SIZES)
SPLIT_POINTS = tuple(int(s) for s in np.cumsum(IN_SIZES)[:-1])

kernel_name = 'hybrid_conv_gla_macaron_block'


def rmsnorm(x, g):
    xf = x.astype(jnp.float32)
    y = xf * lax.rsqrt(jnp.mean(xf * xf, axis=-1, keepdims=True) + EPS)
    return (y * g.astype(jnp.float32)).astype(x.dtype)


def swiglu(x, w_gu, w_down):
    g, u = jnp.split(x @ w_gu, 2, axis=-1)
    return (jax.nn.silu(g) * u) @ w_down


def causal_short_conv(u, w):
    S = u.shape[1]
    up = jnp.pad(u, ((0, 0), (CONV_K - 1, 0), (0, 0)))
    out = up[:, 0:S] * w[0]
    for j in range(1, CONV_K):
        out = out + up[:, j:j + S] * w[j]
    return out


def gla_chunked(q, k, v, log_a):
    B, S = q.shape[0], q.shape[1]
    N = S // CHUNK
    f32 = jnp.float32

    def to_chunks(t):
        return t.reshape(B, N, CHUNK, GLA_HEADS, t.shape[-1]).transpose(0, 3, 1, 2, 4).astype(f32)

    qc = to_chunks(q) * (GLA_DK ** -0.5)
    kc, vc, gc = to_chunks(k), to_chunks(v), to_chunks(log_a)
    b = jnp.cumsum(gc, axis=3)
    b_last = b[:, :, :, -1:]
    b_ref = b[:, :, :, CHUNK // 2 - 1:CHUNK // 2]

    q_ref = qc * jnp.exp(b - b_ref)
    k_ref = kc * jnp.exp(b_ref - b)
    scores = jnp.einsum('bhnid,bhnjd->bhnij', q_ref, k_ref)
    causal = jnp.tril(jnp.ones((CHUNK, CHUNK), dtype=bool))
    scores = jnp.where(causal, scores, 0.0)
    o_intra = jnp.einsum('bhnij,bhnjv->bhniv', scores, vc)

    q_inter = q_ref * jnp.exp(b_ref)
    k_state = kc * jnp.exp(b_last - b)
    kv = jnp.einsum('bhncd,bhncv->nbhdv', k_state, vc)
    decay = jnp.exp(b_last[:, :, :, 0]).transpose(2, 0, 1, 3)

    def step(state, inp):
        dec, kv_n = inp
        return state * dec[..., None] + kv_n, state

    init = jnp.zeros((B, GLA_HEADS, GLA_DK, GLA_DV), f32)
    _, states = lax.scan(step, init, (decay, kv))
    o_inter = jnp.einsum('bhncd,nbhdv->bhncv', q_inter, states)
    o = o_intra + o_inter
    return o.transpose(0, 2, 3, 1, 4).reshape(B, S, GLA_HEADS, GLA_DV)


def hybrid_mixer(h, w_in, conv_w, gate_w_up, gate_b, gla_norm_g, w_out_conv, w_out_gla, w_o):
    B, S, _ = h.shape
    z = h @ w_in
    cb, cc, cu, q, k, v, g_lr, r, ga, gb = jnp.split(z, SPLIT_POINTS, axis=-1)

    y_conv = (cb * causal_short_conv(cc * cu, conv_w)) @ w_out_conv

    log_a = jax.nn.log_sigmoid((g_lr @ gate_w_up + gate_b).astype(jnp.float32)) / GATE_TAU
    o = gla_chunked(q.reshape(B, S, GLA_HEADS, GLA_DK),
                    k.reshape(B, S, GLA_HEADS, GLA_DK),
                    v.reshape(B, S, GLA_HEADS, GLA_DV),
                    log_a.reshape(B, S, GLA_HEADS, GLA_DK))
    o = o * lax.rsqrt(jnp.mean(o * o, axis=-1, keepdims=True) + EPS)
    o = o.reshape(B, S, GLA_V) * gla_norm_g.astype(jnp.float32)
    y_gla = (o.astype(h.dtype) * jax.nn.silu(r)) @ w_out_gla

    merged = jax.nn.sigmoid(ga) * y_conv + jax.nn.sigmoid(gb) * y_gla
    return merged @ w_o


def setup_inputs(seed: int = 0) -> dict:
    key = jax.random.key(seed)
    ks = jax.random.split(key, 20)
    f32 = jnp.float32

    def nrm(k, shape, fan_in):
        return jax.random.normal(k, shape, f32) * (fan_in ** -0.5)

    def gain(k, shape):
        return 1.0 + 0.02 * jax.random.normal(k, shape, f32)

    L = DEPTH
    return {
        'x': jax.random.normal(ks[0], (BATCH, SEQ, D_MODEL), f32),
        'norm_ffn1_g': gain(ks[1], (L, D_MODEL)),
        'ffn1_w_gu': nrm(ks[2], (L, D_MODEL, 2 * D_FF), D_MODEL),
        'ffn1_w_down': nrm(ks[3], (L, D_FF, D_MODEL), D_FF),
        'norm_mix_g': gain(ks[4], (L, D_MODEL)),
        'w_in': nrm(ks[5], (L, D_MODEL, IN_COLS), D_MODEL),
        'conv_w': nrm(ks[6], (L, CONV_K, CONV_DIM), CONV_K),
        'gate_w_up': nrm(ks[7], (L, GATE_RANK, GLA_QK), GATE_RANK),
        'gate_b': 0.1 * jax.random.normal(ks[8], (L, GLA_QK), f32),
        'gla_norm_g': gain(ks[9], (L, GLA_V)),
        'w_out_conv': nrm(ks[10], (L, CONV_DIM, D_MODEL), CONV_DIM),
        'w_out_gla': nrm(ks[11], (L, GLA_V, D_MODEL), GLA_V),
        'w_o': nrm(ks[12], (L, D_MODEL, D_MODEL), D_MODEL),
        'norm_ffn2_g': gain(ks[13], (L, D_MODEL)),
        'ffn2_w_gu': nrm(ks[14], (L, D_MODEL, 2 * D_FF), D_MODEL),
        'ffn2_w_down': nrm(ks[15], (L, D_FF, D_MODEL), D_FF),
        'final_norm_g': gain(ks[16], (D_MODEL,)),
    }


def reference(x, norm_ffn1_g, ffn1_w_gu, ffn1_w_down, norm_mix_g, w_in, conv_w, gate_w_up, gate_b,
              gla_norm_g, w_out_conv, w_out_gla, w_o, norm_ffn2_g, ffn2_w_gu, ffn2_w_down, final_norm_g):
    for l in range(DEPTH):
        x = x + FFN_RES_WEIGHT * swiglu(rmsnorm(x, norm_ffn1_g[l]), ffn1_w_gu[l], ffn1_w_down[l])
        x = x + hybrid_mixer(rmsnorm(x, norm_mix_g[l]), w_in[l], conv_w[l], gate_w_up[l], gate_b[l],
                             gla_norm_g[l], w_out_conv[l], w_out_gla[l], w_o[l])
        x = x + FFN_RES_WEIGHT * swiglu(rmsnorm(x, norm_ffn2_g[l]), ffn2_w_gu[l], ffn2_w_down[l])
    return rmsnorm(x, final_norm_g)
```

```cpp
#include <hip/hip_runtime.h>
#include <hip/hip_cooperative_groups.h>
#include <cstdio>
#include <cstdint>
namespace cg = cooperative_groups;
namespace pg8 {
#define PG8_LAS __attribute__((address_space(3)))
typedef unsigned short bf16_t;
typedef short bf16x8 __attribute__((ext_vector_type(8)));
typedef float f32x4 __attribute__((ext_vector_type(4)));
typedef unsigned u32x4 __attribute__((ext_vector_type(4)));
constexpr int BM = 256, BK = 64, HALF = 128, HTB = HALF * BK * 2  , STAGE_BYTES = 8 * HTB, NXCD = 8, WGM = 8;

__host__ __device__ __forceinline__ int lds_byte(int r, int c) { const int st = (r >> 4) * 2 + (c >> 5), rr = r & 15, cc = c & 31, ob = rr * 64 + cc * 2; return st * 1024 + (ob ^ (((ob >> 9) & 1) << 5)); }
__host__ __device__ __forceinline__ void stage_rc(int b, int& R, int& C) { const int st = b / 1024, sb = b % 1024, swz = sb ^ (((sb >> 9) & 1) << 5); R = (st >> 1) * 16 + swz / 64; C = (st & 1) * 32 + (swz % 64) / 2; }
__host__ __device__ __forceinline__ int perm32(int rho) { const int n = rho >> 4, i = rho & 15; return 8 * (i >> 2) + 4 * n + (i & 3); }

struct Unit { int pm, pn; };
struct Gemm { const bf16_t* A; const bf16_t* Bt; int M, N, K; };

struct StaticOrder {
    int nM, nN, nwg, G, c;
    __host__ __device__ void init(int M, int N, int G_, int c_) { nM = M / BM; nN = N / BM; nwg = nM * nN; G = G_; c = c_; }
    __host__ __device__ bool next(int i, Unit& u) const {
        const long L = (long)i * G + c; if (L >= nwg) return false;
        int wgid = (int)L; { const int q = nwg / NXCD, r = nwg % NXCD, xcd = wgid % NXCD, off = wgid / NXCD; wgid = (xcd < r ? xcd * (q + 1) : r * (q + 1) + (xcd - r) * q) + off; }
        const int nig = WGM * nN, gid = wgid / nig, fm = gid * WGM, gsz = (nM - fm) < WGM ? (nM - fm) : WGM;
        u.pm = fm + ((wgid % nig) % gsz); u.pn = (wgid % nig) / gsz; return true;
    }
    __device__ __forceinline__ void a_ready(const Unit&) const {}
    __device__ __forceinline__ void done(const Unit&) const {}
};
typedef float f32x2_cv __attribute__((ext_vector_type(2))); typedef __bf16 bf16x2_cv __attribute__((ext_vector_type(2)));
__device__ __forceinline__ unsigned cvt_pk_bf16(float lo, float hi) { const f32x2_cv v = {lo, hi}; const bf16x2_cv b = __builtin_convertvector(v, bf16x2_cv); return __builtin_bit_cast(unsigned, b); }
typedef float f32x2 __attribute__((ext_vector_type(2)));
typedef unsigned u32x2 __attribute__((ext_vector_type(2)));
__device__ __forceinline__ float bflo(unsigned w) { return __uint_as_float(w << 16); }
__device__ __forceinline__ float bfhi(unsigned w) { return __uint_as_float(w & 0xffff0000u); }
__device__ __forceinline__ float sigmoid_f(float x) { return __builtin_amdgcn_rcpf(1.0f + __builtin_amdgcn_exp2f(-1.4426950408889634f * x)); }
__device__ __forceinline__ float silu_f(float x) { return x * sigmoid_f(x); }
__device__ __forceinline__ u32x4 pack8(const f32x4& v0, const f32x4& v1) { u32x4 w; w.x = cvt_pk_bf16(v0[0], v0[1]); w.y = cvt_pk_bf16(v0[2], v0[3]); w.z = cvt_pk_bf16(v1[0], v1[1]); w.w = cvt_pk_bf16(v1[2], v1[3]); return w; }
__device__ __forceinline__ void unpack8(const u32x4& w, f32x4& v0, f32x4& v1) { v0 = (f32x4){bflo(w.x), bfhi(w.x), bflo(w.y), bfhi(w.y)}; v1 = (f32x4){bflo(w.z), bfhi(w.z), bflo(w.w), bfhi(w.w)}; }

#define PIN4(a,b,c,d) asm volatile("" : "+v"(a), "+v"(b), "+v"(c), "+v"(d))
struct EpiSwiglu {
    static constexpr bool PERM = true, AFTER_DRAIN = false;
    bf16_t* O; int ldc;
    __device__ __forceinline__ void operator()(const f32x4 (&acc)[2][2][4][2], const Unit& u, int wr, int wc, int fr, int fq) const {
        const int row0 = u.pm * BM + wr * 64 + fr, col0 = u.pn * HALF + wc * 32 + 8 * fq;
#pragma unroll
        for (int ai = 0; ai < 2; ++ai)
#pragma unroll
            for (int m = 0; m < 4; ++m) { bf16_t* rowp = O + (size_t)(row0 + ai * HALF + m * 16) * ldc + col0;
                f32x4 g0 = acc[ai][0][m][0], g1 = acc[ai][0][m][1], u0 = acc[ai][1][m][0], u1 = acc[ai][1][m][1]; PIN4(g0, g1, u0, u1);
                f32x4 v0, v1;
#pragma unroll
                for (int j = 0; j < 4; ++j) { v0[j] = silu_f(g0[j]) * u0[j]; v1[j] = silu_f(g1[j]) * u1[j]; }
                *(u32x4*)rowp = pack8(v0, v1); asm volatile("" ::: "memory"); }
    }
};
struct EpiRes {
    static constexpr bool PERM = false, AFTER_DRAIN = false;
    const float* base; float* out; int ldc; float alpha;
    __device__ __forceinline__ void operator()(const f32x4 (&acc)[2][2][4][2], const Unit& u, int wr, int wc, int fr, int fq) const {
        const int row0 = u.pm * BM + wr * 64 + fr, col0 = u.pn * BM + wc * 32 + 4 * fq;
#pragma unroll
        for (int ai = 0; ai < 2; ++ai)
#pragma unroll
            for (int m = 0; m < 4; ++m) { const size_t off = (size_t)(row0 + ai * HALF + m * 16) * ldc + col0;
#pragma unroll
                for (int bj = 0; bj < 2; ++bj)
#pragma unroll
                    for (int n = 0; n < 2; ++n) { const f32x4 b = *(const f32x4*)(base + off + bj * HALF + n * 16); *(f32x4*)(out + off + bj * HALF + n * 16) = b + alpha * acc[ai][bj][m][n]; }
                asm volatile("" ::: "memory"); }
    }
};
template <int ACT> __device__ __forceinline__ void store_tile_bf16(const f32x4 (&acc)[2][2][4][2], bf16_t* O, int ldc, int row0, int colt, int wc, int fq, float scale) {
    const int col0 = colt + wc * 32 + 8 * fq;
#pragma unroll
    for (int ai = 0; ai < 2; ++ai)
#pragma unroll
        for (int m = 0; m < 4; ++m) { bf16_t* rowp = O + (size_t)(row0 + ai * HALF + m * 16) * ldc + col0;
#pragma unroll
            for (int bj = 0; bj < 2; ++bj) { f32x4 v0 = acc[ai][bj][m][0], v1 = acc[ai][bj][m][1]; asm volatile("" : "+v"(v0), "+v"(v1));
                if (ACT == 0) { v0 = v0 * scale; v1 = v1 * scale; }
                if (ACT == 1) {
#pragma unroll
                    for (int j = 0; j < 4; ++j) { v0[j] = silu_f(v0[j]); v1[j] = silu_f(v1[j]); } }
                if (ACT == 2) {
#pragma unroll
                    for (int j = 0; j < 4; ++j) { v0[j] = sigmoid_f(v0[j]); v1[j] = sigmoid_f(v1[j]); } }
                *(u32x4*)(rowp + bj * HALF) = pack8(v0, v1); asm volatile("" ::: "memory"); } }
}
struct EpiZa {
    static constexpr bool PERM = true, AFTER_DRAIN = false;
    bf16_t *Q, *K, *V, *R;
    __device__ __forceinline__ void operator()(const f32x4 (&acc)[2][2][4][2], const Unit& u, int wr, int wc, int fr, int fq) const {
        const int row0 = u.pm * BM + wr * 64 + fr, pn = u.pn;
        if (pn < 2) store_tile_bf16<0>(acc, Q, 512, row0, pn * BM, wc, fq, 0.08838834764831845f);
        else if (pn < 4) store_tile_bf16<0>(acc, K, 512, row0, (pn - 2) * BM, wc, fq, 1.0f);
        else if (pn < 8) store_tile_bf16<0>(acc, V, 1024, row0, (pn - 4) * BM, wc, fq, 1.0f);
        else store_tile_bf16<1>(acc, R, 1024, row0, (pn - 8) * BM, wc, fq, 1.0f);
    }
};
struct EpiZb {
    static constexpr bool PERM = true, AFTER_DRAIN = false;
    bf16_t *CB, *P, *GA, *GB;
    __device__ __forceinline__ void operator()(const f32x4 (&acc)[2][2][4][2], const Unit& u, int wr, int wc, int fr, int fq) const {
        const int row0 = u.pm * BM + wr * 64 + fr, pn = u.pn;
        if (pn < 4) store_tile_bf16<0>(acc, CB, 1024, row0, pn * BM, wc, fq, 1.0f);
        else if (pn < 12) {
            const int col0 = (pn - 4) * HALF + wc * 32 + 8 * fq;
#pragma unroll
            for (int ai = 0; ai < 2; ++ai)
#pragma unroll
                for (int m = 0; m < 4; ++m) { bf16_t* rowp = P + (size_t)(row0 + ai * HALF + m * 16) * 1024 + col0;
                    *(u32x4*)rowp = pack8(acc[ai][0][m][0] * acc[ai][1][m][0], acc[ai][0][m][1] * acc[ai][1][m][1]); }
        }
        else if (pn < 16) store_tile_bf16<2>(acc, GA, 1024, row0, (pn - 12) * BM, wc, fq, 1.0f);
        else store_tile_bf16<2>(acc, GB, 1024, row0, (pn - 16) * BM, wc, fq, 1.0f);
    }
};
template <int MODE> struct EpiGate {
    static constexpr bool PERM = true, AFTER_DRAIN = false;
    const bf16_t* G; const bf16_t* T; bf16_t* O;
    __device__ __forceinline__ void operator()(const f32x4 (&acc)[2][2][4][2], const Unit& u, int wr, int wc, int fr, int fq) const {
        const int row0 = u.pm * BM + wr * 64 + fr, col0 = u.pn * BM + wc * 32 + 8 * fq;
#pragma unroll
        for (int ai = 0; ai < 2; ++ai)
#pragma unroll
            for (int m = 0; m < 4; ++m) { const size_t off = (size_t)(row0 + ai * HALF + m * 16) * 1024 + col0;
#pragma unroll
                for (int bj = 0; bj < 2; ++bj) {
                    f32x4 g0, g1; unpack8(*(const u32x4*)(G + off + bj * HALF), g0, g1);
                    f32x4 v0 = g0 * acc[ai][bj][m][0], v1 = g1 * acc[ai][bj][m][1];
                    if (MODE == 1) { f32x4 t0, t1; unpack8(*(const u32x4*)(T + off + bj * HALF), t0, t1); v0 = v0 + t0; v1 = v1 + t1; }
                    *(u32x4*)(O + off + bj * HALF) = pack8(v0, v1); }
                asm volatile("" ::: "memory"); }
    }
};

template <class Epi, class Sched, bool ALIGN_EPI = false, bool SP2 = false>
__device__ __forceinline__ void gemm_phase(PG8_LAS unsigned char* lds, const Gemm g, const Sched& S, const Epi& E) {
    const int tid = threadIdx.x, wid = __builtin_amdgcn_readfirstlane(tid >> 6), lane = tid & 63, wr = wid >> 2, wc = wid & 3, fr = lane & 15, fq = lane >> 4;
    const int K = g.K, nt = K / BK;
    unsigned voffA[2], voffB[2];
#pragma unroll
    for (int i = 0; i < 2; ++i) { int R, C; stage_rc(tid * 16 + i * 8192, R, C); const int Rb = Epi::PERM ? ((R & ~31) + perm32(R & 31)) : R;
        voffA[i] = (unsigned)(R * K + C) * 2u; voffB[i] = (unsigned)(Rb * K + C) * 2u; }
    const size_t kstep = (size_t)(BK * 2);
    const size_t hstep = (size_t)HALF * K * 2;
    const size_t tstep = 2 * hstep;
    const unsigned ldsw = (unsigned)wid * 1024u;
    const int aoff = lds_byte(wr * 64 + fr, fq * 8), boff = lds_byte(wc * 32 + fr, fq * 8);
#define PG8_SA(b, h) (((b) * 2 + (h)) * HTB)
#define PG8_SB(b, h) ((4 + (b) * 2 + (h)) * HTB)
#define PG8_STAGE(bufoff, gbase, voff) do { _Pragma("unroll") for (int _i = 0; _i < 2; ++_i) \
        __builtin_amdgcn_global_load_lds((const unsigned*)((const char*)(gbase) + (voff)[_i]), (PG8_LAS unsigned*)(lds + (bufoff) + ldsw + _i * 8192), 16, 0, 0); } while (0)
#define PG8_LDA(dst, b, h) do { _Pragma("unroll") for (int m = 0; m < 4; ++m) _Pragma("unroll") for (int k = 0; k < 2; ++k) dst[m][k] = *(const PG8_LAS bf16x8*)(lds + PG8_SA(b, h) + aoff + m * 2048 + k * 1024); } while (0)
#define PG8_LDB(dst, b, h) do { _Pragma("unroll") for (int n = 0; n < 2; ++n) _Pragma("unroll") for (int k = 0; k < 2; ++k) dst[n][k] = *(const PG8_LAS bf16x8*)(lds + PG8_SB(b, h) + boff + n * 2048 + k * 1024); } while (0)
#define PG8_MMA(ai, bj, At, Bt) do { __builtin_amdgcn_s_setprio(1); _Pragma("unroll") for (int m = 0; m < 4; ++m) _Pragma("unroll") for (int n = 0; n < 2; ++n) _Pragma("unroll") for (int k = 0; k < 2; ++k) \
        acc[ai][bj][m][n] = __builtin_amdgcn_mfma_f32_16x16x32_bf16(Bt[n][k], At[m][k], acc[ai][bj][m][n], 0, 0, 0); __builtin_amdgcn_s_setprio(0); } while (0)
#define PG8_WAIT_V(n) asm volatile("s_waitcnt vmcnt(" #n ")" ::: "memory")
#define PG8_WAIT_L(n) asm volatile("s_waitcnt lgkmcnt(" #n ")" ::: "memory")
#define PG8_BAR __builtin_amdgcn_s_barrier()
#define PG8_SCHED __builtin_amdgcn_sched_barrier(0)
    Unit cur, nxt; int ui = 0;
    if (!S.next(0, cur)) return;
    f32x4 acc[2][2][4][2];
#pragma unroll
    for (int a = 0; a < 2; ++a)
#pragma unroll
        for (int b = 0; b < 2; ++b)
#pragma unroll
            for (int m = 0; m < 4; ++m)
#pragma unroll
                for (int n = 0; n < 2; ++n) acc[a][b][m][n] = (f32x4){0.f, 0.f, 0.f, 0.f};
    bf16x8 At[4][2], B0[2][2], B1[2][2];
    const char* cA = (const char*)g.A + (size_t)cur.pm * tstep; const char* cB = (const char*)g.Bt + (size_t)cur.pn * tstep;
    S.a_ready(cur);
    if constexpr (SP2) {
        PG8_STAGE(PG8_SB(0, 0), cB, voffB); PG8_STAGE(PG8_SB(0, 1), cB + hstep, voffB); PG8_STAGE(PG8_SA(0, 0), cA, voffA); PG8_STAGE(PG8_SA(0, 1), cA + hstep, voffA);
        if (wr == 1) PG8_BAR;
        PG8_WAIT_V(2); PG8_BAR;
        PG8_STAGE(PG8_SB(1, 0), cB + kstep, voffB); PG8_STAGE(PG8_SA(1, 0), cA + kstep, voffA); PG8_STAGE(PG8_SB(1, 1), cB + hstep + kstep, voffB);
        PG8_WAIT_V(6); PG8_BAR;
    } else {
        PG8_STAGE(PG8_SB(0, 0), cB, voffB); PG8_STAGE(PG8_SA(0, 0), cA, voffA); PG8_STAGE(PG8_SB(0, 1), cB + hstep, voffB); PG8_STAGE(PG8_SA(0, 1), cA + hstep, voffA);
        if (wr == 1) PG8_BAR;
        PG8_WAIT_V(4); PG8_BAR;
        PG8_STAGE(PG8_SB(1, 0), cB + kstep, voffB); PG8_STAGE(PG8_SA(1, 0), cA + kstep, voffA); PG8_STAGE(PG8_SB(1, 1), cB + hstep + kstep, voffB);
        PG8_WAIT_V(6); PG8_BAR;
    }
    for (;;) {
        const bool has_next = S.next(ui + 1, nxt);
        const char* nA = has_next ? (const char*)g.A + (size_t)nxt.pm * tstep : cA; const char* nB = has_next ? (const char*)g.Bt + (size_t)nxt.pn * tstep : cB;
        for (int t = 0; t < nt; t += 2) {
            const bool last = (t == nt - 2);
            const char* a1 = cA + (size_t)(t + 1) * kstep;
            const char* a2 = last ? nA : cA + (size_t)(t + 2) * kstep; const char* b2 = last ? nB : cB + (size_t)(t + 2) * kstep;
            const char* a3 = a2 + kstep; const char* b3 = b2 + kstep;
            if (last && has_next) S.a_ready(nxt);
            if constexpr (SP2) {
            PG8_LDB(B0, 0, 0); PG8_LDB(B1, 0, 1); PG8_SCHED; PG8_LDA(At, 0, 0); PG8_STAGE(PG8_SA(1, 1), a1 + hstep, voffA);
            PG8_WAIT_V(8); PG8_WAIT_L(0); PG8_BAR; PG8_MMA(0, 0, At, B0); PG8_MMA(0, 1, At, B1); PG8_BAR; PG8_SCHED;
            PG8_LDA(At, 0, 1); PG8_STAGE(PG8_SB(0, 0), b2, voffB); PG8_STAGE(PG8_SB(0, 1), b2 + hstep, voffB); PG8_STAGE(PG8_SA(0, 0), a2, voffA);
            PG8_WAIT_V(8); PG8_WAIT_L(0); PG8_BAR; PG8_MMA(1, 0, At, B0); PG8_MMA(1, 1, At, B1); PG8_BAR; PG8_SCHED;
            PG8_LDB(B0, 1, 0); PG8_LDB(B1, 1, 1); PG8_SCHED; PG8_LDA(At, 1, 0); PG8_STAGE(PG8_SA(0, 1), a2 + hstep, voffA);
            PG8_WAIT_V(8); PG8_WAIT_L(0); PG8_BAR; PG8_MMA(0, 0, At, B0); PG8_MMA(0, 1, At, B1); PG8_BAR; PG8_SCHED;
            PG8_LDA(At, 1, 1); PG8_STAGE(PG8_SB(1, 0), b3, voffB); PG8_STAGE(PG8_SB(1, 1), b3 + hstep, voffB); PG8_STAGE(PG8_SA(1, 0), a3, voffA);
            PG8_WAIT_V(8); PG8_WAIT_L(0); PG8_BAR; PG8_MMA(1, 0, At, B0); PG8_MMA(1, 1, At, B1); PG8_BAR; PG8_SCHED;
            } else {
            PG8_LDB(B0, 0, 0); PG8_SCHED; PG8_LDA(At, 0, 0); PG8_STAGE(PG8_SA(1, 1), a1 + hstep, voffA);
            PG8_WAIT_L(8); PG8_BAR; PG8_WAIT_L(0); PG8_MMA(0, 0, At, B0); PG8_BAR; PG8_SCHED;
            PG8_LDB(B1, 0, 1); PG8_STAGE(PG8_SB(0, 0), b2, voffB);
            PG8_BAR; PG8_WAIT_L(0); PG8_MMA(0, 1, At, B1); PG8_BAR;
            PG8_LDA(At, 0, 1); PG8_STAGE(PG8_SA(0, 0), a2, voffA);
            PG8_BAR; PG8_WAIT_L(0); PG8_MMA(1, 0, At, B0); PG8_BAR; PG8_SCHED;
            PG8_STAGE(PG8_SB(0, 1), b2 + hstep, voffB);
            PG8_WAIT_V(6); PG8_BAR; PG8_MMA(1, 1, At, B1); PG8_BAR;
            PG8_LDB(B0, 1, 0); PG8_SCHED; PG8_LDA(At, 1, 0); PG8_STAGE(PG8_SA(0, 1), a2 + hstep, voffA);
            PG8_WAIT_L(8); PG8_BAR; PG8_WAIT_L(0); PG8_MMA(0, 0, At, B0); PG8_BAR; PG8_SCHED;
            PG8_LDB(B1, 1, 1); PG8_STAGE(PG8_SB(1, 0), b3, voffB);
            PG8_BAR; PG8_WAIT_L(0); PG8_MMA(0, 1, At, B1); PG8_BAR;
            PG8_LDA(At, 1, 1); PG8_STAGE(PG8_SA(1, 0), a3, voffA);
            PG8_BAR; PG8_WAIT_L(0); PG8_MMA(1, 0, At, B0); PG8_BAR; PG8_SCHED;
            PG8_STAGE(PG8_SB(1, 1), b3 + hstep, voffB);
            PG8_WAIT_V(6); PG8_BAR; PG8_MMA(1, 1, At, B1); PG8_BAR;
            }
        }
        if constexpr (ALIGN_EPI) { if (wr == 0) PG8_BAR; }
        if constexpr (!Epi::AFTER_DRAIN) { E(acc, cur, wr, wc, fr, fq); S.done(cur); }
        if (!has_next) break;
#pragma unroll
        for (int a = 0; a < 2; ++a)
#pragma unroll
            for (int b = 0; b < 2; ++b)
#pragma unroll
                for (int m = 0; m < 4; ++m)
#pragma unroll
                    for (int n = 0; n < 2; ++n) acc[a][b][m][n] = (f32x4){0.f, 0.f, 0.f, 0.f};
        cur = nxt; cA = nA; cB = nB; ++ui;
        if constexpr (ALIGN_EPI) { if (wr == 1) PG8_BAR; }
    }
    PG8_WAIT_V(0);
    if constexpr (!ALIGN_EPI) { if (wr == 0) PG8_BAR; }
    PG8_BAR;
    if constexpr (Epi::AFTER_DRAIN) { E.fused(acc, cur, wr, wc, fr, fq, lds, wid, lane); S.done(cur); }
#undef PG8_SA
#undef PG8_SB
#undef PG8_STAGE
#undef PG8_LDA
#undef PG8_LDB
#undef PG8_MMA
#undef PG8_WAIT_V
#undef PG8_WAIT_L
#undef PG8_BAR
#undef PG8_SCHED
}
}
constexpr int NWAVES = 8, NT = NWAVES * 64;
constexpr int M = 16384, D = 1024, FF = 2816, SEQ = 4096, NCH = 64  , NITEM = 16 * NCH  ;
constexpr int INC = 8208;
constexpr float EPS = 1e-6f;
constexpr size_t MiB = 1u << 20;
constexpr size_t WS_GLR = 1 * MiB;
constexpr size_t WS_DEC = 2 * MiB;
constexpr size_t WS_WGLR = 2 * MiB + 768 * 1024;
constexpr size_t WS_WGU = 3 * MiB;
constexpr size_t WS_WD = 14 * MiB;
constexpr size_t WS_WIN = 20 * MiB;
constexpr size_t WS_WOC = 36 * MiB, WS_WOG = 38 * MiB, WS_WO = 40 * MiB;
constexpr size_t WS_H = 44 * MiB;
constexpr size_t WS_ACT = 76 * MiB;
constexpr size_t WS_Q = 76 * MiB, WS_K = 92 * MiB, WS_V = 108 * MiB, WS_R = 140 * MiB  , WS_KV = 172 * MiB;
constexpr size_t WS_CB = 76 * MiB  , WS_P = 108 * MiB  , WS_GA = 172 * MiB, WS_GB = 204 * MiB;
constexpr size_t WS_END = 236 * MiB;
constexpr int LDS_BYTES = 147456;

#define LAS __attribute__((address_space(3)))
typedef unsigned short bf16;
typedef float f32x4 __attribute__((ext_vector_type(4)));
typedef short bf16x8 __attribute__((ext_vector_type(8)));
typedef unsigned u32x4 __attribute__((ext_vector_type(4)));
typedef unsigned u32x2 __attribute__((ext_vector_type(2)));
using pg8::cvt_pk_bf16; using pg8::bflo; using pg8::bfhi;
#define LDS_WAIT() asm volatile("s_waitcnt lgkmcnt(0)" ::: "memory")
#define MFMA16(a, b, c) __builtin_amdgcn_mfma_f32_16x16x32_bf16((a), (b), (c), 0, 0, 0)

__device__ __forceinline__ float wave_sum(float v) {
#pragma unroll
    for (int o = 1; o < 64; o <<= 1) v += __shfl_xor(v, o);
    return v;
}
__device__ __forceinline__ float bf2f(bf16 b) { return __uint_as_float(((unsigned)b) << 16); }

__device__ __forceinline__ void tr_item(const float* W, int N, int K, int k0, int src_n0, bf16* WT, int dst_row0, LAS float* scr, int lane) {
#pragma unroll 8
    for (int i = 0; i < 32; ++i) { const int kk = 2 * i + (lane >> 5); scr[kk * 33 + (lane & 31)] = W[(size_t)(k0 + kk) * N + src_n0 + (lane & 31)]; }
    LDS_WAIT(); asm volatile("" ::: "memory");
    const int c = lane & 7;
#pragma unroll
    for (int j = 0; j < 4; ++j) { const int n = (lane >> 3) + 8 * j; const LAS float* s = scr + (8 * c) * 33 + n;
        u32x4 o; o.x = cvt_pk_bf16(s[0 * 33], s[1 * 33]); o.y = cvt_pk_bf16(s[2 * 33], s[3 * 33]); o.z = cvt_pk_bf16(s[4 * 33], s[5 * 33]); o.w = cvt_pk_bf16(s[6 * 33], s[7 * 33]);
        *(u32x4*)(WT + (size_t)(dst_row0 + n) * K + k0 + 8 * c) = o; }
    LDS_WAIT(); asm volatile("" ::: "memory");
}
__device__ __forceinline__ int src_gu(int d0) { const int tile = d0 >> 8, half = (d0 >> 7) & 1, off = d0 & 127; return half * FF + 128 * tile + off; }
__device__ __forceinline__ int src_win(int d0) {
    if (d0 < 512) return 3072 + d0;
    if (d0 < 1024) return 3584 + (d0 - 512);
    if (d0 < 2048) return 4096 + (d0 - 1024);
    if (d0 < 3072) return 5136 + (d0 - 2048);
    if (d0 < 4096) return d0 - 3072;
    if (d0 < 6144) { const int j = d0 - 4096, tile = j >> 8, half = (j >> 7) & 1, off = j & 127; return (half ? 2048 : 1024) + 128 * tile + off; }
    if (d0 < 7168) return 6160 + (d0 - 6144);
    return 7184 + (d0 - 7168);
}
template <int KIND> __device__ __forceinline__ void tr_matrix(const float* W, int N, int K, int Ndst, bf16* WT, LAS float* scr, int gw, int ngw, int lane) {
    const int nblk = Ndst / 32, items = (K / 64) * nblk;
    for (int it = gw; it < items; it += ngw) { const int kb = it / nblk, nb = it % nblk, d0 = nb * 32;
        const int s0 = KIND == 0 ? d0 : (KIND == 1 ? src_gu(d0) : src_win(d0));
        tr_item(W, N, K, kb * 64, s0, WT, d0, scr, lane); }
}
__device__ __forceinline__ void norm_row_bf16(const float* xrow, const float* g, bf16* orow, int lane) {
    const f32x4* xr = (const f32x4*)xrow + lane; f32x4 v[4]; float s = 0.f;
#pragma unroll
    for (int j = 0; j < 4; ++j) { v[j] = xr[64 * j]; s += (v[j].x * v[j].x + v[j].y * v[j].y) + (v[j].z * v[j].z + v[j].w * v[j].w); }
    const float rinv = rsqrtf(wave_sum(s) * (1.f / D) + EPS);
    u32x2* o8 = (u32x2*)orow + lane;
#pragma unroll
    for (int j = 0; j < 4; ++j) { const f32x4 gg = ((const f32x4*)g)[lane + 64 * j]; const f32x4 o = v[j] * rinv * gg; u32x2 w; w.x = cvt_pk_bf16(o.x, o.y); w.y = cvt_pk_bf16(o.z, o.w); o8[64 * j] = w; }
}
__device__ __forceinline__ void norm_row_f32(const float* xrow, const float* g, float* orow, int lane) {
    const f32x4* xr = (const f32x4*)xrow + lane; f32x4 v[4]; float s = 0.f;
#pragma unroll
    for (int j = 0; j < 4; ++j) { v[j] = xr[64 * j]; s += (v[j].x * v[j].x + v[j].y * v[j].y) + (v[j].z * v[j].z + v[j].w * v[j].w); }
    const float rinv = rsqrtf(wave_sum(s) * (1.f / D) + EPS);
#pragma unroll
    for (int j = 0; j < 4; ++j) { const f32x4 gg = ((const f32x4*)g)[lane + 64 * j]; ((f32x4*)orow)[lane + 64 * j] = v[j] * rinv * gg; }
}
__device__ __forceinline__ void norm_mix_16(const float* X, const float* g, const bf16* WglrT, bf16* H, float* GLR, int r0, int lane) {
    const int fr = lane & 15, fq = lane >> 4;
    const float* xr = X + (size_t)(r0 + fr) * D + fq * 8;
    float ss = 0.f;
#pragma unroll 8
    for (int s = 0; s < 32; ++s) { const f32x4 a = *(const f32x4*)(xr + 32 * s), b = *(const f32x4*)(xr + 32 * s + 4);
        ss += (a.x * a.x + a.y * a.y) + (a.z * a.z + a.w * a.w) + (b.x * b.x + b.y * b.y) + (b.z * b.z + b.w * b.w); }
    ss += __shfl_xor(ss, 16); ss += __shfl_xor(ss, 32);
    const float rinv = rsqrtf(ss * (1.f / D) + EPS);
    f32x4 acc = {0.f, 0.f, 0.f, 0.f};
    bf16* hr = H + (size_t)(r0 + fr) * D + fq * 8; const bf16* wrp = WglrT + fr * D + fq * 8; const float* gp = g + fq * 8;
#pragma unroll 4
    for (int s = 0; s < 32; ++s) { const f32x4 a = *(const f32x4*)(xr + 32 * s), b = *(const f32x4*)(xr + 32 * s + 4);
        const f32x4 ga = *(const f32x4*)(gp + 32 * s), gb = *(const f32x4*)(gp + 32 * s + 4);
        const f32x4 ha = a * rinv * ga, hb = b * rinv * gb;
        u32x4 hv; hv.x = cvt_pk_bf16(ha.x, ha.y); hv.y = cvt_pk_bf16(ha.z, ha.w); hv.z = cvt_pk_bf16(hb.x, hb.y); hv.w = cvt_pk_bf16(hb.z, hb.w);
        *(u32x4*)(hr + 32 * s) = hv;
        const bf16x8 af = __builtin_bit_cast(bf16x8, hv); const bf16x8 bfv = *(const bf16x8*)(wrp + 32 * s);
        acc = MFMA16(af, bfv, acc); }
#pragma unroll
    for (int j = 0; j < 4; ++j) GLR[(size_t)(r0 + fq * 4 + j) * 16 + fr] = acc[j];
}

__device__ __forceinline__ float logsig16(float x) { const float e = __expf(-fabsf(x)); return (fminf(x, 0.f) - __logf(1.0f + e)) * (1.0f / 16.0f); }

struct GlaPtrs { const float* GLR; const float* Wup; const float* gate_b; const float* gnorm; const bf16* Q; const bf16* K; const bf16* V; bf16* RY; bf16* KV; float* DEC; };

#define GLA_GATE_PREFIX() \
    const int d = tid & 127, tg = tid >> 7; \
    float wup[16]; \
    _Pragma("unroll") for (int j = 0; j < 16; ++j) wup[j] = P.Wup[j * 512 + h * 128 + d]; \
    const float gbias = P.gate_b[h * 128 + d]; \
    if (tid < 256) ((LAS f32x4*)glr_s)[tid] = ((const f32x4*)(P.GLR + (size_t)row0 * 16))[tid];

__device__ __forceinline__ void gla_a_item(LAS unsigned char* lds, const GlaPtrs& P, int item, int tid) {
    const int bh = item >> 6, n = item & 63, b = bh >> 2, h = bh & 3, row0 = b * SEQ + n * 64;
    LAS float* glr_s = (LAS float*)lds;
    LAS float* gsum = (LAS float*)(lds + 4096);
    LAS bf16* kT = (LAS bf16*)(lds + 8192);
    LAS bf16* vT = (LAS bf16*)(lds + 26624);
    GLA_GATE_PREFIX()
    float kk[16];
#pragma unroll
    for (int i = 0; i < 16; ++i) kk[i] = bf2f(P.K[(size_t)(row0 + tg * 16 + i) * 512 + h * 128 + d]);
    unsigned vw[16];
    { const int vp = tid & 127, tq = tid >> 7;
#pragma unroll
      for (int i = 0; i < 16; ++i) vw[i] = *(const unsigned*)(P.V + (size_t)(row0 + tq * 16 + i) * 1024 + h * 256 + 2 * vp); }
    __syncthreads();
    float bl[16]; float run = 0.f;
#pragma unroll
    for (int i = 0; i < 16; ++i) { float pre = gbias; const LAS f32x4* gr = (const LAS f32x4*)(glr_s + (tg * 16 + i) * 16);
#pragma unroll
        for (int j4 = 0; j4 < 4; ++j4) { const f32x4 gv = gr[j4]; pre += gv.x * wup[4 * j4] + gv.y * wup[4 * j4 + 1] + gv.z * wup[4 * j4 + 2] + gv.w * wup[4 * j4 + 3]; }
        run += logsig16(pre); bl[i] = run; }
    gsum[tg * 128 + d] = run;
    __syncthreads();
    const float g0 = gsum[d], g1 = gsum[128 + d], g2 = gsum[256 + d], g3 = gsum[384 + d];
    const float off = (tg > 0 ? g0 : 0.f) + (tg > 1 ? g1 : 0.f) + (tg > 2 ? g2 : 0.f);
    const float blast = (g0 + g1) + (g2 + g3);
    { float ks[16];
#pragma unroll
      for (int i = 0; i < 16; ++i) ks[i] = kk[i] * __expf(blast - (bl[i] + off));
      u32x4 w0, w1; w0.x = cvt_pk_bf16(ks[0], ks[1]); w0.y = cvt_pk_bf16(ks[2], ks[3]); w0.z = cvt_pk_bf16(ks[4], ks[5]); w0.w = cvt_pk_bf16(ks[6], ks[7]);
      w1.x = cvt_pk_bf16(ks[8], ks[9]); w1.y = cvt_pk_bf16(ks[10], ks[11]); w1.z = cvt_pk_bf16(ks[12], ks[13]); w1.w = cvt_pk_bf16(ks[14], ks[15]);
      *(LAS u32x4*)(kT + d * 72 + tg * 16) = w0; *(LAS u32x4*)(kT + d * 72 + tg * 16 + 8) = w1; }
    if (tg == 0) P.DEC[(size_t)item * 128 + d] = __expf(blast);
    { const int vp = tid & 127, tq = tid >> 7;
      u32x4 l0, l1, h0, h1;
#define PKLO(a, b) (((a) & 0xffffu) | ((b) << 16))
#define PKHI(a, b) (((a) >> 16) | ((b) & 0xffff0000u))
      l0.x = PKLO(vw[0], vw[1]); l0.y = PKLO(vw[2], vw[3]); l0.z = PKLO(vw[4], vw[5]); l0.w = PKLO(vw[6], vw[7]);
      l1.x = PKLO(vw[8], vw[9]); l1.y = PKLO(vw[10], vw[11]); l1.z = PKLO(vw[12], vw[13]); l1.w = PKLO(vw[14], vw[15]);
      h0.x = PKHI(vw[0], vw[1]); h0.y = PKHI(vw[2], vw[3]); h0.z = PKHI(vw[4], vw[5]); h0.w = PKHI(vw[6], vw[7]);
      h1.x = PKHI(vw[8], vw[9]); h1.y = PKHI(vw[10], vw[11]); h1.z = PKHI(vw[12], vw[13]); h1.w = PKHI(vw[14], vw[15]);
      *(LAS u32x4*)(vT + (2 * vp) * 72 + tq * 16) = l0; *(LAS u32x4*)(vT + (2 * vp) * 72 + tq * 16 + 8) = l1;
      *(LAS u32x4*)(vT + (2 * vp + 1) * 72 + tq * 16) = h0; *(LAS u32x4*)(vT + (2 * vp + 1) * 72 + tq * 16 + 8) = h1; }
    __syncthreads();
    { const int w = tid >> 6, lane = tid & 63, fr = lane & 15, fq = lane >> 4;
      bf16x8 vf[2][2];
#pragma unroll
      for (int vt = 0; vt < 2; ++vt)
#pragma unroll
          for (int ks = 0; ks < 2; ++ks) vf[vt][ks] = *(const LAS bf16x8*)(vT + ((2 * w + vt) * 16 + fr) * 72 + ks * 32 + fq * 8);
      bf16* kvb = P.KV + (size_t)item * (256 * 128);
#pragma unroll
      for (int dt = 0; dt < 8; ++dt) {
          const bf16x8 k0 = *(const LAS bf16x8*)(kT + (dt * 16 + fr) * 72 + fq * 8), k1 = *(const LAS bf16x8*)(kT + (dt * 16 + fr) * 72 + 32 + fq * 8);
#pragma unroll
          for (int vt = 0; vt < 2; ++vt) { f32x4 acc = {0.f, 0.f, 0.f, 0.f};
              acc = MFMA16(k0, vf[vt][0], acc); acc = MFMA16(k1, vf[vt][1], acc);
              u32x2 o; o.x = cvt_pk_bf16(acc[0], acc[1]); o.y = cvt_pk_bf16(acc[2], acc[3]);
              *(u32x2*)(kvb + (size_t)((2 * w + vt) * 16 + fr) * 128 + dt * 16 + fq * 4) = o; } } }
    __syncthreads();
}

__device__ __forceinline__ void gla_c_item(LAS unsigned char* lds, const GlaPtrs& P, int item, int tid) {
    const int bh = item >> 6, n = item & 63, b = bh >> 2, h = bh & 3, row0 = b * SEQ + n * 64;
    LAS float* glr_s = (LAS float*)lds;
    LAS float* gsum = (LAS float*)(lds + 4096);
    LAS float* ss_s = (LAS float*)(lds + 6144);
    LAS bf16* qi = (LAS bf16*)(lds + 8192);
    LAS bf16* qr = (LAS bf16*)(lds + 25600);
    LAS bf16* kr = (LAS bf16*)(lds + 43008);
    LAS bf16* vT = (LAS bf16*)(lds + 60416);
    LAS bf16* sc = (LAS bf16*)(lds + 97280);
    GLA_GATE_PREFIX()
    float qq[16], kk[16];
#pragma unroll
    for (int i = 0; i < 16; ++i) { const size_t o = (size_t)(row0 + tg * 16 + i) * 512 + h * 128 + d; qq[i] = bf2f(P.Q[o]); kk[i] = bf2f(P.K[o]); }
    unsigned vw[16];
    { const int vp = tid & 127, tq = tid >> 7;
#pragma unroll
      for (int i = 0; i < 16; ++i) vw[i] = *(const unsigned*)(P.V + (size_t)(row0 + tq * 16 + i) * 1024 + h * 256 + 2 * vp); }
    __syncthreads();
    float bl[16]; float run = 0.f;
#pragma unroll
    for (int i = 0; i < 16; ++i) { float pre = gbias; const LAS f32x4* gr = (const LAS f32x4*)(glr_s + (tg * 16 + i) * 16);
#pragma unroll
        for (int j4 = 0; j4 < 4; ++j4) { const f32x4 gv = gr[j4]; pre += gv.x * wup[4 * j4] + gv.y * wup[4 * j4 + 1] + gv.z * wup[4 * j4 + 2] + gv.w * wup[4 * j4 + 3]; }
        run += logsig16(pre); bl[i] = run; }
    gsum[tg * 128 + d] = run;
    __syncthreads();
    { const float g0 = gsum[d], g1 = gsum[128 + d], g2 = gsum[256 + d];
      const float off = (tg > 0 ? g0 : 0.f) + (tg > 1 ? g1 : 0.f) + (tg > 2 ? g2 : 0.f);
      const float bref = g0 + g1;
#pragma unroll
      for (int i = 0; i < 16; ++i) { const float bb = bl[i] + off; const int t = tg * 16 + i;
          const float e1 = __expf(bb), e2 = __expf(bb - bref), e3 = __expf(bref - bb);
          qi[t * 136 + d] = (bf16)(cvt_pk_bf16(qq[i] * e1, 0.f) & 0xffffu);
          qr[t * 136 + d] = (bf16)(cvt_pk_bf16(qq[i] * e2, 0.f) & 0xffffu);
          kr[t * 136 + d] = (bf16)(cvt_pk_bf16(kk[i] * e3, 0.f) & 0xffffu); } }
    { const int vp = tid & 127, tq = tid >> 7;
      u32x4 l0, l1, h0, h1;
      l0.x = PKLO(vw[0], vw[1]); l0.y = PKLO(vw[2], vw[3]); l0.z = PKLO(vw[4], vw[5]); l0.w = PKLO(vw[6], vw[7]);
      l1.x = PKLO(vw[8], vw[9]); l1.y = PKLO(vw[10], vw[11]); l1.z = PKLO(vw[12], vw[13]); l1.w = PKLO(vw[14], vw[15]);
      h0.x = PKHI(vw[0], vw[1]); h0.y = PKHI(vw[2], vw[3]); h0.z = PKHI(vw[4], vw[5]); h0.w = PKHI(vw[6], vw[7]);
      h1.x = PKHI(vw[8], vw[9]); h1.y = PKHI(vw[10], vw[11]); h1.z = PKHI(vw[12], vw[13]); h1.w = PKHI(vw[14], vw[15]);
      *(LAS u32x4*)(vT + (2 * vp) * 72 + tq * 16) = l0; *(LAS u32x4*)(vT + (2 * vp) * 72 + tq * 16 + 8) = l1;
      *(LAS u32x4*)(vT + (2 * vp + 1) * 72 + tq * 16) = h0; *(LAS u32x4*)(vT + (2 * vp + 1) * 72 + tq * 16 + 8) = h1; }
    __syncthreads();
    const int w = tid >> 6, lane = tid & 63, fr = lane & 15, fq = lane >> 4;
    { const int it = w >> 1;
#pragma unroll
      for (int jj = 0; jj < 2; ++jj) { const int jt = 2 * (w & 1) + jj; f32x4 acc = {0.f, 0.f, 0.f, 0.f};
#pragma unroll
          for (int ks = 0; ks < 4; ++ks) { const bf16x8 x = *(const LAS bf16x8*)(kr + (jt * 16 + fr) * 136 + ks * 32 + fq * 8), y = *(const LAS bf16x8*)(qr + (it * 16 + fr) * 136 + ks * 32 + fq * 8);
              acc = MFMA16(x, y, acc); }
          const int i = it * 16 + fr, j0 = jt * 16 + fq * 4;
          u32x2 o; o.x = cvt_pk_bf16(j0 <= i ? acc[0] : 0.f, j0 + 1 <= i ? acc[1] : 0.f); o.y = cvt_pk_bf16(j0 + 2 <= i ? acc[2] : 0.f, j0 + 3 <= i ? acc[3] : 0.f);
          *(LAS u32x2*)(sc + i * 72 + j0) = o; } }
    __syncthreads();
    f32x4 acc[4][2];
    { const bf16* Sb = P.KV + (size_t)item * (256 * 128);
#pragma unroll
      for (int vt = 0; vt < 2; ++vt) { const int v0 = (2 * w + vt) * 16;
          bf16x8 xv[2], xs[4];
#pragma unroll
          for (int ks = 0; ks < 2; ++ks) xv[ks] = *(const LAS bf16x8*)(vT + (v0 + fr) * 72 + ks * 32 + fq * 8);
#pragma unroll
          for (int ks = 0; ks < 4; ++ks) xs[ks] = *(const bf16x8*)(Sb + (size_t)(v0 + fr) * 128 + ks * 32 + fq * 8);
#pragma unroll
          for (int it = 0; it < 4; ++it) { f32x4 a = {0.f, 0.f, 0.f, 0.f};
#pragma unroll
              for (int ks = 0; ks < 2; ++ks) { const bf16x8 y = *(const LAS bf16x8*)(sc + (it * 16 + fr) * 72 + ks * 32 + fq * 8); a = MFMA16(xv[ks], y, a); }
#pragma unroll
              for (int ks = 0; ks < 4; ++ks) { const bf16x8 y = *(const LAS bf16x8*)(qi + (it * 16 + fr) * 136 + ks * 32 + fq * 8); a = MFMA16(xs[ks], y, a); }
              acc[it][vt] = a; } } }
#pragma unroll
    for (int it = 0; it < 4; ++it) { float p = 0.f;
#pragma unroll
        for (int vt = 0; vt < 2; ++vt) p += (acc[it][vt][0] * acc[it][vt][0] + acc[it][vt][1] * acc[it][vt][1]) + (acc[it][vt][2] * acc[it][vt][2] + acc[it][vt][3] * acc[it][vt][3]);
        p += __shfl_xor(p, 16); p += __shfl_xor(p, 32);
        if (fq == 0) ss_s[w * 64 + it * 16 + fr] = p; }
    __syncthreads();
#pragma unroll
    for (int it = 0; it < 4; ++it) { float tot = 0.f;
#pragma unroll
        for (int ww = 0; ww < 8; ++ww) tot += ss_s[ww * 64 + it * 16 + fr];
        const float rinv = rsqrtf(tot * (1.f / 256.f) + EPS);
#pragma unroll
        for (int vt = 0; vt < 2; ++vt) { const int col = h * 256 + (2 * w + vt) * 16 + fq * 4; bf16* p = P.RY + (size_t)(row0 + it * 16 + fr) * 1024 + col;
            const u32x2 rw = *(const u32x2*)p; const f32x4 gn = *(const f32x4*)(P.gnorm + col); const f32x4 a = acc[it][vt];
            u32x2 o; o.x = cvt_pk_bf16(a[0] * rinv * gn[0] * bflo(rw.x), a[1] * rinv * gn[1] * bfhi(rw.x)); o.y = cvt_pk_bf16(a[2] * rinv * gn[2] * bflo(rw.y), a[3] * rinv * gn[3] * bfhi(rw.y));
            *(u32x2*)p = o; } }
    __syncthreads();
}

__device__ __forceinline__ void gla_scan(bf16* KV, const float* DEC, int gtid, int gthreads) {
    for (int e = gtid; e < 16 * 256 * 32; e += gthreads) { const int bh = e >> 13, rem = e & 8191, v = rem >> 5, d4 = rem & 31;
        bf16* base = KV + ((size_t)(bh * 64) * 256 + v) * 128 + d4 * 4; const float* dc = DEC + (size_t)(bh * 64) * 128 + d4 * 4;
        f32x4 S = {0.f, 0.f, 0.f, 0.f};
        for (int nb = 0; nb < 8; ++nb) { u32x2 kv[8]; f32x4 dv[8];
#pragma unroll
            for (int u = 0; u < 8; ++u) { kv[u] = *(const u32x2*)(base + (size_t)(nb * 8 + u) * 32768); dv[u] = *(const f32x4*)(dc + (nb * 8 + u) * 128); }
#pragma unroll
            for (int u = 0; u < 8; ++u) { u32x2 o; o.x = cvt_pk_bf16(S[0], S[1]); o.y = cvt_pk_bf16(S[2], S[3]); *(u32x2*)(base + (size_t)(nb * 8 + u) * 32768) = o;
                const f32x4 k4 = {bflo(kv[u].x), bfhi(kv[u].x), bflo(kv[u].y), bfhi(kv[u].y)}; S = dv[u] * S + k4; } } }
}
__device__ __forceinline__ void conv_pass(bf16* CB, const bf16* Pp, const float* cw, int gtid, int gthreads) {
    for (int e = gtid; e < M * 128; e += gthreads) { const int row = e >> 7, c = (e & 127) * 8, s = row & (SEQ - 1);
        const u32x4 z = {0u, 0u, 0u, 0u};
        const u32x4 cbw = *(const u32x4*)(CB + (size_t)row * 1024 + c), p0 = *(const u32x4*)(Pp + (size_t)row * 1024 + c);
        const u32x4 p1 = s >= 1 ? *(const u32x4*)(Pp + (size_t)(row - 1) * 1024 + c) : z, p2 = s >= 2 ? *(const u32x4*)(Pp + (size_t)(row - 2) * 1024 + c) : z;
        f32x4 a0, a1, b0, b1, c0, c1, d0, d1; pg8::unpack8(cbw, a0, a1); pg8::unpack8(p0, b0, b1); pg8::unpack8(p1, c0, c1); pg8::unpack8(p2, d0, d1);
        const f32x4 w00 = *(const f32x4*)(cw + c), w01 = *(const f32x4*)(cw + c + 4), w10 = *(const f32x4*)(cw + 1024 + c), w11 = *(const f32x4*)(cw + 1024 + c + 4), w20 = *(const f32x4*)(cw + 2048 + c), w21 = *(const f32x4*)(cw + 2048 + c + 4);
        const f32x4 y0 = a0 * (w00 * d0 + w10 * c0 + w20 * b0), y1 = a1 * (w01 * d1 + w11 * c1 + w21 * b1);
        *(u32x4*)(CB + (size_t)row * 1024 + c) = pg8::pack8(y0, y1); }
}

struct Args { const float* in[17]; float* out; unsigned char* ws; int ph_lo, ph_hi; };
constexpr int NPHASE = 16;
#ifndef MK_SPLIT
#define MK_SPLIT 0
#endif

__global__ void __launch_bounds__(NT, 2) mega_fwd(Args args) {
    extern __shared__ __attribute__((aligned(16))) unsigned char lds_raw[];
    LAS unsigned char* lds = (LAS unsigned char*)lds_raw;
#define FRESH_TID() int tid = threadIdx.x; asm volatile("" : "+v"(tid)); const int lane = tid & 63; const int wave = __builtin_amdgcn_readfirstlane(tid >> 6); \
    const int gw = bx * NWAVES + wave, ngw = G * NWAVES, gtid = bx * NT + tid, gthreads = G * NT; (void)lane; (void)gw; (void)ngw; (void)gtid; (void)gthreads;
    const int G = gridDim.x, bx = blockIdx.x;
    unsigned char* ws = args.ws;
    const float* x = args.in[0]; float* out = args.out;
    bf16* Wgu = (bf16*)(ws + WS_WGU); bf16* Wd = (bf16*)(ws + WS_WD); bf16* Win = (bf16*)(ws + WS_WIN); bf16* Wglr = (bf16*)(ws + WS_WGLR);
    bf16* Woc = (bf16*)(ws + WS_WOC); bf16* Wog = (bf16*)(ws + WS_WOG); bf16* Wo = (bf16*)(ws + WS_WO);
    bf16* H = (bf16*)(ws + WS_H); bf16* ACT = (bf16*)(ws + WS_ACT);
    float* GLR = (float*)(ws + WS_GLR);
    const int lo = args.ph_lo, hi = args.ph_hi;
#define IN(k) (lo <= (k) && (k) < hi)
#if MK_SPLIT
#define SEAM(k) do { } while (0)
#else
#define SEAM(k) do { if (IN(k) && IN((k) + 1)) { asm volatile("s_waitcnt vmcnt(0) lgkmcnt(0)" ::: "memory"); cg::this_grid().sync(); } } while (0)
#endif
#define RUN_GEMM(EPI, Ap, Bp, Nn, Kk, Eobj) do { pg8::Gemm g_{(const pg8::bf16_t*)(Ap), (const pg8::bf16_t*)(Bp), M, (Nn), (Kk)}; pg8::StaticOrder S_; S_.init(M, (Nn), G, bx); \
        pg8::gemm_phase<EPI, pg8::StaticOrder, true, true>(lds, g_, S_, Eobj); } while (0)

    if (IN(0)) { FRESH_TID()
        LAS float* scr = (LAS float*)(lds + wave * 16384);
        tr_matrix<1>(args.in[2], 2 * FF, D, 2 * FF, Wgu, scr, gw, ngw, lane);
        tr_matrix<0>(args.in[3], D, FF, D, Wd, scr, gw, ngw, lane);
        tr_matrix<2>(args.in[5], INC, D, 8192, Win, scr, gw, ngw, lane);
        tr_matrix<0>(args.in[10], D, D, D, Woc, scr, gw, ngw, lane);
        tr_matrix<0>(args.in[11], D, D, D, Wog, scr, gw, ngw, lane);
        tr_matrix<0>(args.in[12], D, D, D, Wo, scr, gw, ngw, lane);
        for (int e = gtid; e < 16 * D; e += gthreads) { const int nn = e >> 10, k = e & 1023; Wglr[e] = (bf16)(cvt_pk_bf16(args.in[5][(size_t)k * INC + 5120 + nn], 0.f) & 0xffffu); }
        for (int m = gw; m < M; m += ngw) norm_row_bf16(x + (size_t)m * D, args.in[1], H + (size_t)m * D, lane);
    }
    SEAM(0);
    if (IN(1)) { pg8::EpiSwiglu E{(pg8::bf16_t*)ACT, FF}; RUN_GEMM(pg8::EpiSwiglu, H, Wgu, 2 * FF, D, E); }
    SEAM(1);
    if (IN(2)) { pg8::EpiRes E{x, out, D, 0.5f}; RUN_GEMM(pg8::EpiRes, ACT, Wd, D, FF, E); }
    SEAM(2);
    if (IN(3)) { FRESH_TID() for (int r = gw; r < M / 16; r += ngw) norm_mix_16(out, args.in[4], Wglr, H, GLR, r * 16, lane); }
    SEAM(3);
    if (IN(4)) { pg8::EpiZa E{(pg8::bf16_t*)(ws + WS_Q), (pg8::bf16_t*)(ws + WS_K), (pg8::bf16_t*)(ws + WS_V), (pg8::bf16_t*)(ws + WS_R)}; RUN_GEMM(pg8::EpiZa, H, Win, 3072, D, E); }
    SEAM(4);
    GlaPtrs GP{GLR, args.in[7], args.in[8], args.in[9], (const bf16*)(ws + WS_Q), (const bf16*)(ws + WS_K), (const bf16*)(ws + WS_V), (bf16*)(ws + WS_R), (bf16*)(ws + WS_KV), (float*)(ws + WS_DEC)};
    if (IN(5)) { FRESH_TID() for (int it = bx; it < NITEM; it += G) gla_a_item(lds, GP, it, tid); }
    SEAM(5);
    if (IN(6)) { FRESH_TID() gla_scan((bf16*)(ws + WS_KV), (const float*)(ws + WS_DEC), gtid, gthreads); }
    SEAM(6);
    if (IN(7)) { FRESH_TID() for (int it = bx; it < NITEM; it += G) gla_c_item(lds, GP, it, tid); }
    SEAM(7);
    if (IN(8)) { pg8::EpiZb E{(pg8::bf16_t*)(ws + WS_CB), (pg8::bf16_t*)(ws + WS_P), (pg8::bf16_t*)(ws + WS_GA), (pg8::bf16_t*)(ws + WS_GB)}; RUN_GEMM(pg8::EpiZb, H, Win + (size_t)3072 * D, 5120, D, E); }
    SEAM(8);
    if (IN(9)) { FRESH_TID() conv_pass((bf16*)(ws + WS_CB), (const bf16*)(ws + WS_P), args.in[6], gtid, gthreads); }
    SEAM(9);
    if (IN(10)) {
        { pg8::EpiGate<0> E{(const pg8::bf16_t*)(ws + WS_GA), nullptr, (pg8::bf16_t*)(ws + WS_P)}; RUN_GEMM(pg8::EpiGate<0>, ws + WS_CB, Woc, D, D, E); }
        { pg8::EpiGate<1> E{(const pg8::bf16_t*)(ws + WS_GB), (const pg8::bf16_t*)(ws + WS_P), (pg8::bf16_t*)(ws + WS_H)}; RUN_GEMM(pg8::EpiGate<1>, ws + WS_R, Wog, D, D, E); }
    }
    SEAM(10);
    if (IN(11)) { pg8::EpiRes E{out, out, D, 1.0f}; RUN_GEMM(pg8::EpiRes, H, Wo, D, D, E); }
    SEAM(11);
    if (IN(12)) { FRESH_TID()
        LAS float* scr = (LAS float*)(lds + wave * 16384);
        tr_matrix<1>(args.in[14], 2 * FF, D, 2 * FF, Wgu, scr, gw, ngw, lane);
        tr_matrix<0>(args.in[15], D, FF, D, Wd, scr, gw, ngw, lane);
        for (int m = gw; m < M; m += ngw) norm_row_bf16(out + (size_t)m * D, args.in[13], H + (size_t)m * D, lane);
    }
    SEAM(12);
    if (IN(13)) { pg8::EpiSwiglu E{(pg8::bf16_t*)ACT, FF}; RUN_GEMM(pg8::EpiSwiglu, H, Wgu, 2 * FF, D, E); }
    SEAM(13);
    if (IN(14)) { pg8::EpiRes E{out, out, D, 0.5f}; RUN_GEMM(pg8::EpiRes, ACT, Wd, D, FF, E); }
    SEAM(14);
    if (IN(15)) { FRESH_TID() for (int m = gw; m < M; m += ngw) norm_row_f32(out + (size_t)m * D, args.in[16], out + (size_t)m * D, lane); }
}

extern "C" void kernel_launch(void* const* d_in, const int* in_sizes, int n_in, void* d_out, int out_size, void* d_ws, size_t ws_size, hipStream_t stream) {
    static int grid = 0;
    if (grid == 0) {
        if (n_in != 17 || in_sizes[0] != M * D || out_size != M * D || ws_size < WS_END) { fprintf(stderr, "kernel_launch: unexpected shapes / workspace (n_in %d, ws %zu)\n", n_in, ws_size); grid = -1; return; }
        int dev = 0, cus = 0, per_cu = 0;
        hipGetDevice(&dev); hipDeviceGetAttribute(&cus, hipDeviceAttributeMultiprocessorCount, dev);
        if (hipFuncSetAttribute((const void*)mega_fwd, hipFuncAttributeMaxDynamicSharedMemorySize, LDS_BYTES) != hipSuccess) { fprintf(stderr, "kernel_launch: hipFuncSetAttribute failed\n"); grid = -1; return; }
        if (hipOccupancyMaxActiveBlocksPerMultiprocessor(&per_cu, (const void*)mega_fwd, NT, LDS_BYTES) != hipSuccess || per_cu < 1) { per_cu = 1; (void)hipGetLastError(); }
        grid = cus * per_cu;
    }
    if (grid < 0) return;
    Args a{};
    for (int i = 0; i < 17; ++i) a.in[i] = (const float*)d_in[i];
    a.out = (float*)d_out; a.ws = (unsigned char*)d_ws;
#if MK_SPLIT
    for (int p = 0; p < NPHASE; ++p) { a.ph_lo = p; a.ph_hi = p + 1; hipLaunchKernelGGL(mega_fwd, dim3(grid), dim3(NT), LDS_BYTES, stream, a); }
#else
    a.ph_lo = 0; a.ph_hi = NPHASE;
    void* kargs[] = {&a};
    hipError_t e = hipLaunchCooperativeKernel((const void*)mega_fwd, dim3(grid), dim3(NT), kargs, LDS_BYTES, stream);
    if (e != hipSuccess) fprintf(stderr, "cooperative launch failed: %s (grid %d)\n", hipGetErrorString(e), grid);
#endif
}
```

```cpp
#include <hip/hip_runtime.h>
#include <hip/hip_cooperative_groups.h>
#include <cstdio>
#include <cstdint>
namespace cg = cooperative_groups;
namespace pg8 {
#define PG8_LAS __attribute__((address_space(3)))
typedef unsigned short bf16_t;
typedef short bf16x8 __attribute__((ext_vector_type(8)));
typedef float f32x4 __attribute__((ext_vector_type(4)));
typedef unsigned u32x4 __attribute__((ext_vector_type(4)));
constexpr int BM = 256, BK = 64, HALF = 128, HTB = HALF * BK * 2  , STAGE_BYTES = 8 * HTB, NXCD = 8, WGM = 8;

__host__ __device__ __forceinline__ int lds_byte(int r, int c) { const int st = (r >> 4) * 2 + (c >> 5), rr = r & 15, cc = c & 31, ob = rr * 64 + cc * 2; return st * 1024 + (ob ^ (((ob >> 9) & 1) << 5)); }
__host__ __device__ __forceinline__ void stage_rc(int b, int& R, int& C) { const int st = b / 1024, sb = b % 1024, swz = sb ^ (((sb >> 9) & 1) << 5); R = (st >> 1) * 16 + swz / 64; C = (st & 1) * 32 + (swz % 64) / 2; }
__host__ __device__ __forceinline__ int perm32(int rho) { const int n = rho >> 4, i = rho & 15; return 8 * (i >> 2) + 4 * n + (i & 3); }

struct Unit { int pm, pn; };
struct Gemm { const bf16_t* A; const bf16_t* Bt; int M, N, K; };

struct StaticOrder {
    int nM, nN, nwg, G, c;
    __host__ __device__ void init(int M, int N, int G_, int c_) { nM = M / BM; nN = N / BM; nwg = nM * nN; G = G_; c = c_; }
    __host__ __device__ bool next(int i, Unit& u) const {
        const long L = (long)i * G + c; if (L >= nwg) return false;
        int wgid = (int)L; { const int q = nwg / NXCD, r = nwg % NXCD, xcd = wgid % NXCD, off = wgid / NXCD; wgid = (xcd < r ? xcd * (q + 1) : r * (q + 1) + (xcd - r) * q) + off; }
        const int nig = WGM * nN, gid = wgid / nig, fm = gid * WGM, gsz = (nM - fm) < WGM ? (nM - fm) : WGM;
        u.pm = fm + ((wgid % nig) % gsz); u.pn = (wgid % nig) / gsz; return true;
    }
    __device__ __forceinline__ void a_ready(const Unit&) const {}
    __device__ __forceinline__ void done(const Unit&) const {}
};
typedef float f32x2_cv __attribute__((ext_vector_type(2))); typedef __bf16 bf16x2_cv __attribute__((ext_vector_type(2)));
__device__ __forceinline__ unsigned cvt_pk_bf16(float lo, float hi) { const f32x2_cv v = {lo, hi}; const bf16x2_cv b = __builtin_convertvector(v, bf16x2_cv); return __builtin_bit_cast(unsigned, b); }
typedef float f32x2 __attribute__((ext_vector_type(2)));
typedef unsigned u32x2 __attribute__((ext_vector_type(2)));
__device__ __forceinline__ float bflo(unsigned w) { return __uint_as_float(w << 16); }
__device__ __forceinline__ float bfhi(unsigned w) { return __uint_as_float(w & 0xffff0000u); }
__device__ __forceinline__ float sigmoid_f(float x) { return __builtin_amdgcn_rcpf(1.0f + __builtin_amdgcn_exp2f(-1.4426950408889634f * x)); }
__device__ __forceinline__ float silu_f(float x) { return x * sigmoid_f(x); }
__device__ __forceinline__ u32x4 pack8(const f32x4& v0, const f32x4& v1) { u32x4 w; w.x = cvt_pk_bf16(v0[0], v0[1]); w.y = cvt_pk_bf16(v0[2], v0[3]); w.z = cvt_pk_bf16(v1[0], v1[1]); w.w = cvt_pk_bf16(v1[2], v1[3]); return w; }
__device__ __forceinline__ void unpack8(const u32x4& w, f32x4& v0, f32x4& v1) { v0 = (f32x4){bflo(w.x), bfhi(w.x), bflo(w.y), bfhi(w.y)}; v1 = (f32x4){bflo(w.z), bfhi(w.z), bflo(w.w), bfhi(w.w)}; }

__device__ __forceinline__ float row_rinv(const float* ss, int row) { const f32x4* p = (const f32x4*)(ss + (size_t)row * 16); const f32x4 a = p[0], b = p[1], c = p[2], d = p[3];
    const f32x4 t = (a + b) + (c + d); return rsqrtf(((t[0] + t[1]) + (t[2] + t[3])) * (1.0f / 1024.0f) + 1e-6f); }
typedef const PG8_LAS float* rtab_t;
#define PIN4(a,b,c,d) asm volatile("" : "+v"(a), "+v"(b), "+v"(c), "+v"(d))
struct EpiSwiglu {
    static constexpr bool PERM = true, AFTER_DRAIN = false;
    bf16_t* O; int ldc; rtab_t rt;
    __device__ __forceinline__ void operator()(const f32x4 (&acc)[2][2][4][2], const Unit& u, int wr, int wc, int fr, int fq, int ui) const {
        const int row0 = u.pm * BM + wr * 64 + fr, col0 = u.pn * HALF + wc * 32 + 8 * fq;
#pragma unroll
        for (int ai = 0; ai < 2; ++ai)
#pragma unroll
            for (int m = 0; m < 4; ++m) { const int row = row0 + ai * HALF + m * 16; bf16_t* rowp = O + (size_t)row * ldc + col0; const float ri = rt[ui * 256 + wr * 64 + fr + ai * HALF + m * 16];
                f32x4 g0 = acc[ai][0][m][0], g1 = acc[ai][0][m][1], u0 = acc[ai][1][m][0], u1 = acc[ai][1][m][1]; PIN4(g0, g1, u0, u1);
                g0 = g0 * ri; g1 = g1 * ri; u0 = u0 * ri; u1 = u1 * ri;
                f32x4 v0, v1;
#pragma unroll
                for (int j = 0; j < 4; ++j) { v0[j] = silu_f(g0[j]) * u0[j]; v1[j] = silu_f(g1[j]) * u1[j]; }
                *(u32x4*)rowp = pack8(v0, v1); asm volatile("" ::: "memory"); }
    }
};
template <bool WITH_HB> struct EpiRes {
    static constexpr bool PERM = false, AFTER_DRAIN = false;
    const float* base; float* out; int ldc; float alpha; bf16_t* HB; float* ss;
    __device__ __forceinline__ void operator()(const f32x4 (&acc)[2][2][4][2], const Unit& u, int wr, int wc, int fr, int fq, int ui) const {
        const int row0 = u.pm * BM + wr * 64 + fr, col0 = u.pn * BM + wc * 32 + 4 * fq;
#pragma unroll
        for (int ai = 0; ai < 2; ++ai)
#pragma unroll
            for (int m = 0; m < 4; ++m) { const int row = row0 + ai * HALF + m * 16; const size_t off = (size_t)row * ldc + col0; float p = 0.f;
#pragma unroll
                for (int bj = 0; bj < 2; ++bj)
#pragma unroll
                    for (int n = 0; n < 2; ++n) { const f32x4 b = *(const f32x4*)(base + off + bj * HALF + n * 16); const f32x4 o = b + alpha * acc[ai][bj][m][n];
                        *(f32x4*)(out + off + bj * HALF + n * 16) = o; p += (o[0] * o[0] + o[1] * o[1]) + (o[2] * o[2] + o[3] * o[3]);
                        if (WITH_HB) { u32x2 w; w.x = cvt_pk_bf16(o[0], o[1]); w.y = cvt_pk_bf16(o[2], o[3]); *(u32x2*)(HB + off + bj * HALF + n * 16) = w; } }
                p += __shfl_xor(p, 16); p += __shfl_xor(p, 32);
                if (fq == 0) ss[(size_t)row * 16 + u.pn * 4 + wc] = p;
                asm volatile("" ::: "memory"); }
    }
};
template <int ACT> __device__ __forceinline__ void store_tile_bf16(const f32x4 (&acc)[2][2][4][2], bf16_t* O, int ldc, int row0, int colt, int wc, int fq, float scale, rtab_t rt) {
    const int col0 = colt + wc * 32 + 8 * fq;
#pragma unroll
    for (int ai = 0; ai < 2; ++ai)
#pragma unroll
        for (int m = 0; m < 4; ++m) { const int row = row0 + ai * HALF + m * 16; bf16_t* rowp = O + (size_t)row * ldc + col0; const float ri = rt[(row & 255)] * scale;
#pragma unroll
            for (int bj = 0; bj < 2; ++bj) { f32x4 v0 = acc[ai][bj][m][0], v1 = acc[ai][bj][m][1]; asm volatile("" : "+v"(v0), "+v"(v1));
                v0 = v0 * ri; v1 = v1 * ri;
                if (ACT == 1) {
#pragma unroll
                    for (int j = 0; j < 4; ++j) { v0[j] = silu_f(v0[j]); v1[j] = silu_f(v1[j]); } }
                if (ACT == 2) {
#pragma unroll
                    for (int j = 0; j < 4; ++j) { v0[j] = sigmoid_f(v0[j]); v1[j] = sigmoid_f(v1[j]); } }
                *(u32x4*)(rowp + bj * HALF) = pack8(v0, v1); asm volatile("" ::: "memory"); } }
}
struct EpiZa {
    static constexpr bool PERM = true, AFTER_DRAIN = false;
    bf16_t *Q, *K, *V, *R; rtab_t rt;
    __device__ __forceinline__ void operator()(const f32x4 (&acc)[2][2][4][2], const Unit& u, int wr, int wc, int fr, int fq, int ui) const {
        const int row0 = u.pm * BM + wr * 64 + fr, pn = u.pn;
        if (pn < 2) store_tile_bf16<0>(acc, Q, 512, row0, pn * BM, wc, fq, 0.08838834764831845f, rt + ui * 256);
        else if (pn < 4) store_tile_bf16<0>(acc, K, 512, row0, (pn - 2) * BM, wc, fq, 1.0f, rt + ui * 256);
        else if (pn < 8) store_tile_bf16<0>(acc, V, 1024, row0, (pn - 4) * BM, wc, fq, 1.0f, rt + ui * 256);
        else store_tile_bf16<1>(acc, R, 1024, row0, (pn - 8) * BM, wc, fq, 1.0f, rt + ui * 256);
    }
};
struct EpiZb {
    static constexpr bool PERM = true, AFTER_DRAIN = false;
    bf16_t *CB, *P, *GA, *GB; rtab_t rt;
    __device__ __forceinline__ void operator()(const f32x4 (&acc)[2][2][4][2], const Unit& u, int wr, int wc, int fr, int fq, int ui) const {
        const int row0 = u.pm * BM + wr * 64 + fr, pn = u.pn;
        if (pn < 4) store_tile_bf16<0>(acc, CB, 1024, row0, pn * BM, wc, fq, 1.0f, rt + ui * 256);
        else if (pn < 12) {
            const int col0 = (pn - 4) * HALF + wc * 32 + 8 * fq;
#pragma unroll
            for (int ai = 0; ai < 2; ++ai)
#pragma unroll
                for (int m = 0; m < 4; ++m) { const int row = row0 + ai * HALF + m * 16; bf16_t* rowp = P + (size_t)row * 1024 + col0; const float ri = rt[ui * 256 + (row & 255)], ri2 = ri * ri;
                    *(u32x4*)rowp = pack8(acc[ai][0][m][0] * acc[ai][1][m][0] * ri2, acc[ai][0][m][1] * acc[ai][1][m][1] * ri2); }
        }
        else if (pn < 16) store_tile_bf16<2>(acc, GA, 1024, row0, (pn - 12) * BM, wc, fq, 1.0f, rt + ui * 256);
        else store_tile_bf16<2>(acc, GB, 1024, row0, (pn - 16) * BM, wc, fq, 1.0f, rt + ui * 256);
    }
};
template <int MODE> struct EpiGate {
    static constexpr bool PERM = true, AFTER_DRAIN = false;
    const bf16_t* G; const bf16_t* T; bf16_t* O;
    __device__ __forceinline__ void operator()(const f32x4 (&acc)[2][2][4][2], const Unit& u, int wr, int wc, int fr, int fq, int ui) const {
        const int row0 = u.pm * BM + wr * 64 + fr, col0 = u.pn * BM + wc * 32 + 8 * fq;
#pragma unroll
        for (int ai = 0; ai < 2; ++ai)
#pragma unroll
            for (int m = 0; m < 4; ++m) { const size_t off = (size_t)(row0 + ai * HALF + m * 16) * 1024 + col0;
#pragma unroll
                for (int bj = 0; bj < 2; ++bj) {
                    f32x4 g0, g1; unpack8(*(const u32x4*)(G + off + bj * HALF), g0, g1);
                    f32x4 v0 = g0 * acc[ai][bj][m][0], v1 = g1 * acc[ai][bj][m][1];
                    if (MODE == 1) { f32x4 t0, t1; unpack8(*(const u32x4*)(T + off + bj * HALF), t0, t1); v0 = v0 + t0; v1 = v1 + t1; }
                    *(u32x4*)(O + off + bj * HALF) = pack8(v0, v1); }
                asm volatile("" ::: "memory"); }
    }
};

template <class Epi, class Sched, bool ALIGN_EPI = false, bool SP2 = false>
__device__ __forceinline__ void gemm_phase(PG8_LAS unsigned char* lds, const Gemm g, const Sched& S, const Epi& E) {
    const int tid = threadIdx.x, wid = __builtin_amdgcn_readfirstlane(tid >> 6), lane = tid & 63, wr = wid >> 2, wc = wid & 3, fr = lane & 15, fq = lane >> 4;
    const int K = g.K, nt = K / BK;
    unsigned voffA[2], voffB[2];
#pragma unroll
    for (int i = 0; i < 2; ++i) { int R, C; stage_rc(tid * 16 + i * 8192, R, C); const int Rb = Epi::PERM ? ((R & ~31) + perm32(R & 31)) : R;
        voffA[i] = (unsigned)(R * K + C) * 2u; voffB[i] = (unsigned)(Rb * K + C) * 2u; }
    const size_t kstep = (size_t)(BK * 2);
    const size_t hstep = (size_t)HALF * K * 2;
    const size_t tstep = 2 * hstep;
    const unsigned ldsw = (unsigned)wid * 1024u;
    const int aoff = lds_byte(wr * 64 + fr, fq * 8), boff = lds_byte(wc * 32 + fr, fq * 8);
#define PG8_SA(b, h) (((b) * 2 + (h)) * HTB)
#define PG8_SB(b, h) ((4 + (b) * 2 + (h)) * HTB)
#define PG8_STAGE(bufoff, gbase, voff) do { _Pragma("unroll") for (int _i = 0; _i < 2; ++_i) \
        __builtin_amdgcn_global_load_lds((const unsigned*)((const char*)(gbase) + (voff)[_i]), (PG8_LAS unsigned*)(lds + (bufoff) + ldsw + _i * 8192), 16, 0, 0); } while (0)
#define PG8_LDA(dst, b, h) do { _Pragma("unroll") for (int m = 0; m < 4; ++m) _Pragma("unroll") for (int k = 0; k < 2; ++k) dst[m][k] = *(const PG8_LAS bf16x8*)(lds + PG8_SA(b, h) + aoff + m * 2048 + k * 1024); } while (0)
#define PG8_LDB(dst, b, h) do { _Pragma("unroll") for (int n = 0; n < 2; ++n) _Pragma("unroll") for (int k = 0; k < 2; ++k) dst[n][k] = *(const PG8_LAS bf16x8*)(lds + PG8_SB(b, h) + boff + n * 2048 + k * 1024); } while (0)
#define PG8_MMA(ai, bj, At, Bt) do { __builtin_amdgcn_s_setprio(1); _Pragma("unroll") for (int m = 0; m < 4; ++m) _Pragma("unroll") for (int n = 0; n < 2; ++n) _Pragma("unroll") for (int k = 0; k < 2; ++k) \
        acc[ai][bj][m][n] = __builtin_amdgcn_mfma_f32_16x16x32_bf16(Bt[n][k], At[m][k], acc[ai][bj][m][n], 0, 0, 0); __builtin_amdgcn_s_setprio(0); } while (0)
#define PG8_WAIT_V(n) asm volatile("s_waitcnt vmcnt(" #n ")" ::: "memory")
#define PG8_WAIT_L(n) asm volatile("s_waitcnt lgkmcnt(" #n ")" ::: "memory")
#define PG8_BAR __builtin_amdgcn_s_barrier()
#define PG8_SCHED __builtin_amdgcn_sched_barrier(0)
    Unit cur, nxt; int ui = 0;
    if (!S.next(0, cur)) return;
    f32x4 acc[2][2][4][2];
#pragma unroll
    for (int a = 0; a < 2; ++a)
#pragma unroll
        for (int b = 0; b < 2; ++b)
#pragma unroll
            for (int m = 0; m < 4; ++m)
#pragma unroll
                for (int n = 0; n < 2; ++n) acc[a][b][m][n] = (f32x4){0.f, 0.f, 0.f, 0.f};
    bf16x8 At[4][2], B0[2][2], B1[2][2];
    const char* cA = (const char*)g.A + (size_t)cur.pm * tstep; const char* cB = (const char*)g.Bt + (size_t)cur.pn * tstep;
    S.a_ready(cur);
    if constexpr (SP2) {
        PG8_STAGE(PG8_SB(0, 0), cB, voffB); PG8_STAGE(PG8_SB(0, 1), cB + hstep, voffB); PG8_STAGE(PG8_SA(0, 0), cA, voffA); PG8_STAGE(PG8_SA(0, 1), cA + hstep, voffA);
        if (wr == 1) PG8_BAR;
        PG8_WAIT_V(2); PG8_BAR;
        PG8_STAGE(PG8_SB(1, 0), cB + kstep, voffB); PG8_STAGE(PG8_SA(1, 0), cA + kstep, voffA); PG8_STAGE(PG8_SB(1, 1), cB + hstep + kstep, voffB);
        PG8_WAIT_V(6); PG8_BAR;
    } else {
        PG8_STAGE(PG8_SB(0, 0), cB, voffB); PG8_STAGE(PG8_SA(0, 0), cA, voffA); PG8_STAGE(PG8_SB(0, 1), cB + hstep, voffB); PG8_STAGE(PG8_SA(0, 1), cA + hstep, voffA);
        if (wr == 1) PG8_BAR;
        PG8_WAIT_V(4); PG8_BAR;
        PG8_STAGE(PG8_SB(1, 0), cB + kstep, voffB); PG8_STAGE(PG8_SA(1, 0), cA + kstep, voffA); PG8_STAGE(PG8_SB(1, 1), cB + hstep + kstep, voffB);
        PG8_WAIT_V(6); PG8_BAR;
    }
    for (;;) {
        const bool has_next = S.next(ui + 1, nxt);
        const char* nA = has_next ? (const char*)g.A + (size_t)nxt.pm * tstep : cA; const char* nB = has_next ? (const char*)g.Bt + (size_t)nxt.pn * tstep : cB;
        for (int t = 0; t < nt; t += 2) {
            const bool last = (t == nt - 2);
            const char* a1 = cA + (size_t)(t + 1) * kstep;
            const char* a2 = last ? nA : cA + (size_t)(t + 2) * kstep; const char* b2 = last ? nB : cB + (size_t)(t + 2) * kstep;
            const char* a3 = a2 + kstep; const char* b3 = b2 + kstep;
            if (last && has_next) S.a_ready(nxt);
            if constexpr (SP2) {
            PG8_LDB(B0, 0, 0); PG8_LDB(B1, 0, 1); PG8_SCHED; PG8_LDA(At, 0, 0); PG8_STAGE(PG8_SA(1, 1), a1 + hstep, voffA);
            PG8_WAIT_V(8); PG8_WAIT_L(0); PG8_BAR; PG8_MMA(0, 0, At, B0); PG8_MMA(0, 1, At, B1); PG8_BAR; PG8_SCHED;
            PG8_LDA(At, 0, 1); PG8_STAGE(PG8_SB(0, 0), b2, voffB); PG8_STAGE(PG8_SB(0, 1), b2 + hstep, voffB); PG8_STAGE(PG8_SA(0, 0), a2, voffA);
            PG8_WAIT_V(8); PG8_WAIT_L(0); PG8_BAR; PG8_MMA(1, 0, At, B0); PG8_MMA(1, 1, At, B1); PG8_BAR; PG8_SCHED;
            PG8_LDB(B0, 1, 0); PG8_LDB(B1, 1, 1); PG8_SCHED; PG8_LDA(At, 1, 0); PG8_STAGE(PG8_SA(0, 1), a2 + hstep, voffA);
            PG8_WAIT_V(8); PG8_WAIT_L(0); PG8_BAR; PG8_MMA(0, 0, At, B0); PG8_MMA(0, 1, At, B1); PG8_BAR; PG8_SCHED;
            PG8_LDA(At, 1, 1); PG8_STAGE(PG8_SB(1, 0), b3, voffB); PG8_STAGE(PG8_SB(1, 1), b3 + hstep, voffB); PG8_STAGE(PG8_SA(1, 0), a3, voffA);
            PG8_WAIT_V(8); PG8_WAIT_L(0); PG8_BAR; PG8_MMA(1, 0, At, B0); PG8_MMA(1, 1, At, B1); PG8_BAR; PG8_SCHED;
            } else {
            PG8_LDB(B0, 0, 0); PG8_SCHED; PG8_LDA(At, 0, 0); PG8_STAGE(PG8_SA(1, 1), a1 + hstep, voffA);
            PG8_WAIT_L(8); PG8_BAR; PG8_WAIT_L(0); PG8_MMA(0, 0, At, B0); PG8_BAR; PG8_SCHED;
            PG8_LDB(B1, 0, 1); PG8_STAGE(PG8_SB(0, 0), b2, voffB);
            PG8_BAR; PG8_WAIT_L(0); PG8_MMA(0, 1, At, B1); PG8_BAR;
            PG8_LDA(At, 0, 1); PG8_STAGE(PG8_SA(0, 0), a2, voffA);
            PG8_BAR; PG8_WAIT_L(0); PG8_MMA(1, 0, At, B0); PG8_BAR; PG8_SCHED;
            PG8_STAGE(PG8_SB(0, 1), b2 + hstep, voffB);
            PG8_WAIT_V(6); PG8_BAR; PG8_MMA(1, 1, At, B1); PG8_BAR;
            PG8_LDB(B0, 1, 0); PG8_SCHED; PG8_LDA(At, 1, 0); PG8_STAGE(PG8_SA(0, 1), a2 + hstep, voffA);
            PG8_WAIT_L(8); PG8_BAR; PG8_WAIT_L(0); PG8_MMA(0, 0, At, B0); PG8_BAR; PG8_SCHED;
            PG8_LDB(B1, 1, 1); PG8_STAGE(PG8_SB(1, 0), b3, voffB);
            PG8_BAR; PG8_WAIT_L(0); PG8_MMA(0, 1, At, B1); PG8_BAR;
            PG8_LDA(At, 1, 1); PG8_STAGE(PG8_SA(1, 0), a3, voffA);
            PG8_BAR; PG8_WAIT_L(0); PG8_MMA(1, 0, At, B0); PG8_BAR; PG8_SCHED;
            PG8_STAGE(PG8_SB(1, 1), b3 + hstep, voffB);
            PG8_WAIT_V(6); PG8_BAR; PG8_MMA(1, 1, At, B1); PG8_BAR;
            }
        }
        if constexpr (ALIGN_EPI) { if (wr == 0) PG8_BAR; }
        if constexpr (!Epi::AFTER_DRAIN) { E(acc, cur, wr, wc, fr, fq, ui); S.done(cur); }
        if (!has_next) break;
#pragma unroll
        for (int a = 0; a < 2; ++a)
#pragma unroll
            for (int b = 0; b < 2; ++b)
#pragma unroll
                for (int m = 0; m < 4; ++m)
#pragma unroll
                    for (int n = 0; n < 2; ++n) acc[a][b][m][n] = (f32x4){0.f, 0.f, 0.f, 0.f};
        cur = nxt; cA = nA; cB = nB; ++ui;
        if constexpr (ALIGN_EPI) { if (wr == 1) PG8_BAR; }
    }
    PG8_WAIT_V(0);
    if constexpr (!ALIGN_EPI) { if (wr == 0) PG8_BAR; }
    PG8_BAR;
    if constexpr (Epi::AFTER_DRAIN) { E.fused(acc, cur, wr, wc, fr, fq, lds, wid, lane); S.done(cur); }
#undef PG8_SA
#undef PG8_SB
#undef PG8_STAGE
#undef PG8_LDA
#undef PG8_LDB
#undef PG8_MMA
#undef PG8_WAIT_V
#undef PG8_WAIT_L
#undef PG8_BAR
#undef PG8_SCHED
}
}
constexpr int NWAVES = 8, NT = NWAVES * 64;
constexpr int M = 16384, D = 1024, FF = 2816, SEQ = 4096, NCH = 64  , NITEM = 16 * NCH  ;
constexpr int INC = 8208;
constexpr float EPS = 1e-6f;
constexpr size_t MiB = 1u << 20;
constexpr size_t WS_CTL = 0, CTL_ZERO_BYTES = 64 * 1024;
constexpr size_t WS_SS1 = 240 * MiB, WS_SS2 = 241 * MiB, WS_SS3 = 242 * MiB, WS_SS4 = 243 * MiB;
constexpr size_t WS_HB3 = 204 * MiB;
constexpr size_t WS_GLR = 1 * MiB;
constexpr size_t WS_DEC = 2 * MiB;
constexpr size_t WS_WGLR = 2 * MiB + 768 * 1024;
constexpr size_t WS_WGU = 3 * MiB;
constexpr size_t WS_WD = 14 * MiB;
constexpr size_t WS_WIN = 20 * MiB;
constexpr size_t WS_WOC = 36 * MiB, WS_WOG = 38 * MiB, WS_WO = 40 * MiB;
constexpr size_t WS_H = 44 * MiB;
constexpr size_t WS_ACT = 76 * MiB;
constexpr size_t WS_Q = 76 * MiB, WS_K = 92 * MiB, WS_V = 108 * MiB, WS_R = 140 * MiB  , WS_KV = 172 * MiB;
constexpr size_t WS_CB = 76 * MiB  , WS_P = 108 * MiB  , WS_GA = 172 * MiB, WS_GB = 204 * MiB;
constexpr size_t WS_END = 244 * MiB;
constexpr int LDS_BYTES = 147456;

#define LAS __attribute__((address_space(3)))
typedef unsigned short bf16;
typedef float f32x4 __attribute__((ext_vector_type(4)));
typedef short bf16x8 __attribute__((ext_vector_type(8)));
typedef unsigned u32x4 __attribute__((ext_vector_type(4)));
typedef unsigned u32x2 __attribute__((ext_vector_type(2)));
using pg8::cvt_pk_bf16; using pg8::bflo; using pg8::bfhi;
#define LDS_WAIT() asm volatile("s_waitcnt lgkmcnt(0)" ::: "memory")
#define MFMA16(a, b, c) __builtin_amdgcn_mfma_f32_16x16x32_bf16((a), (b), (c), 0, 0, 0)

__device__ __forceinline__ float wave_sum(float v) {
#pragma unroll
    for (int o = 1; o < 64; o <<= 1) v += __shfl_xor(v, o);
    return v;
}
__device__ __forceinline__ float bf2f(bf16 b) { return __uint_as_float(((unsigned)b) << 16); }

__device__ __forceinline__ void tr_item(const float* W, int N, int K, int k0, int src_n0, bf16* WT, int dst_row0, LAS float* scr, int lane, const float* gk) {
#pragma unroll 8
    for (int i = 0; i < 32; ++i) { const int kk = 2 * i + (lane >> 5); scr[kk * 33 + (lane & 31)] = W[(size_t)(k0 + kk) * N + src_n0 + (lane & 31)]; }
    LDS_WAIT(); asm volatile("" ::: "memory");
    const int c = lane & 7;
    f32x4 ga = {1.f, 1.f, 1.f, 1.f}, gb = ga; if (gk) { ga = *(const f32x4*)(gk + k0 + 8 * c); gb = *(const f32x4*)(gk + k0 + 8 * c + 4); }
#pragma unroll
    for (int j = 0; j < 4; ++j) { const int n = (lane >> 3) + 8 * j; const LAS float* s = scr + (8 * c) * 33 + n;
        u32x4 o; o.x = cvt_pk_bf16(s[0 * 33] * ga[0], s[1 * 33] * ga[1]); o.y = cvt_pk_bf16(s[2 * 33] * ga[2], s[3 * 33] * ga[3]); o.z = cvt_pk_bf16(s[4 * 33] * gb[0], s[5 * 33] * gb[1]); o.w = cvt_pk_bf16(s[6 * 33] * gb[2], s[7 * 33] * gb[3]);
        *(u32x4*)(WT + (size_t)(dst_row0 + n) * K + k0 + 8 * c) = o; }
    LDS_WAIT(); asm volatile("" ::: "memory");
}
__device__ __forceinline__ int src_gu(int d0) { const int tile = d0 >> 8, half = (d0 >> 7) & 1, off = d0 & 127; return half * FF + 128 * tile + off; }
__device__ __forceinline__ int src_win(int d0) {
    if (d0 < 512) return 3072 + d0;
    if (d0 < 1024) return 3584 + (d0 - 512);
    if (d0 < 2048) return 4096 + (d0 - 1024);
    if (d0 < 3072) return 5136 + (d0 - 2048);
    if (d0 < 4096) return d0 - 3072;
    if (d0 < 6144) { const int j = d0 - 4096, tile = j >> 8, half = (j >> 7) & 1, off = j & 127; return (half ? 2048 : 1024) + 128 * tile + off; }
    if (d0 < 7168) return 6160 + (d0 - 6144);
    return 7184 + (d0 - 7168);
}
template <int KIND> __device__ __forceinline__ void tr_matrix(const float* W, int N, int K, int Ndst, bf16* WT, LAS float* scr, int gw, int ngw, int lane, const float* gk) {
    const int nblk = Ndst / 32, items = (K / 64) * nblk;
    for (int it = gw; it < items; it += ngw) { const int kb = it / nblk, nb = it % nblk, d0 = nb * 32;
        const int s0 = KIND == 0 ? d0 : (KIND == 1 ? src_gu(d0) : src_win(d0));
        tr_item(W, N, K, kb * 64, s0, WT, d0, scr, lane, gk); }
}
__device__ __forceinline__ void norm_row_bf16(const float* xrow, const float* g, bf16* orow, int lane) {
    const f32x4* xr = (const f32x4*)xrow + lane; f32x4 v[4]; float s = 0.f;
#pragma unroll
    for (int j = 0; j < 4; ++j) { v[j] = xr[64 * j]; s += (v[j].x * v[j].x + v[j].y * v[j].y) + (v[j].z * v[j].z + v[j].w * v[j].w); }
    const float rinv = rsqrtf(wave_sum(s) * (1.f / D) + EPS);
    u32x2* o8 = (u32x2*)orow + lane;
#pragma unroll
    for (int j = 0; j < 4; ++j) { const f32x4 gg = ((const f32x4*)g)[lane + 64 * j]; const f32x4 o = v[j] * rinv * gg; u32x2 w; w.x = cvt_pk_bf16(o.x, o.y); w.y = cvt_pk_bf16(o.z, o.w); o8[64 * j] = w; }
}
__device__ __forceinline__ void cvt_row_bf16(const float* xrow, bf16* orow, float* ssp, int lane) {
    const f32x4* xr = (const f32x4*)xrow + lane; f32x4 v[4]; float s = 0.f;
#pragma unroll
    for (int j = 0; j < 4; ++j) { v[j] = xr[64 * j]; s += (v[j].x * v[j].x + v[j].y * v[j].y) + (v[j].z * v[j].z + v[j].w * v[j].w); }
    s = wave_sum(s); if (lane < 16) ssp[lane] = lane == 0 ? s : 0.f;
    u32x2* o8 = (u32x2*)orow + lane;
#pragma unroll
    for (int j = 0; j < 4; ++j) { u32x2 w; w.x = cvt_pk_bf16(v[j].x, v[j].y); w.y = cvt_pk_bf16(v[j].z, v[j].w); o8[64 * j] = w; }
}
__device__ __forceinline__ void glr_16(const bf16* HB, const bf16* WglrT, const float* ss, float* GLR, int r0, int lane) {
    const int fr = lane & 15, fq = lane >> 4;
    const bf16* hr = HB + (size_t)(r0 + fr) * D + fq * 8; const bf16* wrp = WglrT + fr * D + fq * 8;
    f32x4 acc = {0.f, 0.f, 0.f, 0.f};
#pragma unroll 8
    for (int s = 0; s < 32; ++s) { const bf16x8 af = *(const bf16x8*)(hr + 32 * s), bfv = *(const bf16x8*)(wrp + 32 * s); acc = MFMA16(af, bfv, acc); }
#pragma unroll
    for (int j = 0; j < 4; ++j) { const int row = r0 + fq * 4 + j; GLR[(size_t)row * 16 + fr] = acc[j] * pg8::row_rinv(ss, row); }
}
__device__ __forceinline__ void norm_row_f32(const float* xrow, const float* g, float* orow, int lane) {
    const f32x4* xr = (const f32x4*)xrow + lane; f32x4 v[4]; float s = 0.f;
#pragma unroll
    for (int j = 0; j < 4; ++j) { v[j] = xr[64 * j]; s += (v[j].x * v[j].x + v[j].y * v[j].y) + (v[j].z * v[j].z + v[j].w * v[j].w); }
    const float rinv = rsqrtf(wave_sum(s) * (1.f / D) + EPS);
#pragma unroll
    for (int j = 0; j < 4; ++j) { const f32x4 gg = ((const f32x4*)g)[lane + 64 * j]; ((f32x4*)orow)[lane + 64 * j] = v[j] * rinv * gg; }
}
__device__ __forceinline__ void norm_mix_16(const float* X, const float* g, const bf16* WglrT, bf16* H, float* GLR, int r0, int lane) {
    const int fr = lane & 15, fq = lane >> 4;
    const float* xr = X + (size_t)(r0 + fr) * D + fq * 8;
    float ss = 0.f;
#pragma unroll 8
    for (int s = 0; s < 32; ++s) { const f32x4 a = *(const f32x4*)(xr + 32 * s), b = *(const f32x4*)(xr + 32 * s + 4);
        ss += (a.x * a.x + a.y * a.y) + (a.z * a.z + a.w * a.w) + (b.x * b.x + b.y * b.y) + (b.z * b.z + b.w * b.w); }
    ss += __shfl_xor(ss, 16); ss += __shfl_xor(ss, 32);
    const float rinv = rsqrtf(ss * (1.f / D) + EPS);
    f32x4 acc = {0.f, 0.f, 0.f, 0.f};
    bf16* hr = H + (size_t)(r0 + fr) * D + fq * 8; const bf16* wrp = WglrT + fr * D + fq * 8; const float* gp = g + fq * 8;
#pragma unroll 4
    for (int s = 0; s < 32; ++s) { const f32x4 a = *(const f32x4*)(xr + 32 * s), b = *(const f32x4*)(xr + 32 * s + 4);
        const f32x4 ga = *(const f32x4*)(gp + 32 * s), gb = *(const f32x4*)(gp + 32 * s + 4);
        const f32x4 ha = a * rinv * ga, hb = b * rinv * gb;
        u32x4 hv; hv.x = cvt_pk_bf16(ha.x, ha.y); hv.y = cvt_pk_bf16(ha.z, ha.w); hv.z = cvt_pk_bf16(hb.x, hb.y); hv.w = cvt_pk_bf16(hb.z, hb.w);
        *(u32x4*)(hr + 32 * s) = hv;
        const bf16x8 af = __builtin_bit_cast(bf16x8, hv); const bf16x8 bfv = *(const bf16x8*)(wrp + 32 * s);
        acc = MFMA16(af, bfv, acc); }
#pragma unroll
    for (int j = 0; j < 4; ++j) GLR[(size_t)(r0 + fq * 4 + j) * 16 + fr] = acc[j];
}

__device__ __forceinline__ float logsig16(float x) { const float e = __expf(-fabsf(x)); return (fminf(x, 0.f) - __logf(1.0f + e)) * (1.0f / 16.0f); }

struct GlaPtrs { const float* GLR; const float* Wup; const float* gate_b; const float* gnorm; const bf16* Q; const bf16* K; const bf16* V; bf16* RY; bf16* KV; float* DEC; };

#define GLA_GATE_PREFIX() \
    const int d = tid & 127, tg = tid >> 7; \
    float wup[16]; \
    _Pragma("unroll") for (int j = 0; j < 16; ++j) wup[j] = P.Wup[j * 512 + h * 128 + d]; \
    const float gbias = P.gate_b[h * 128 + d]; \
    if (tid < 256) ((LAS f32x4*)glr_s)[tid] = ((const f32x4*)(P.GLR + (size_t)row0 * 16))[tid];

__device__ __forceinline__ void gla_a_item(LAS unsigned char* lds, const GlaPtrs& P, int item, int tid) {
    const int bh = item >> 6, n = item & 63, b = bh >> 2, h = bh & 3, row0 = b * SEQ + n * 64;
    LAS float* glr_s = (LAS float*)lds;
    LAS float* gsum = (LAS float*)(lds + 4096);
    LAS bf16* kT = (LAS bf16*)(lds + 8192);
    LAS bf16* vT = (LAS bf16*)(lds + 26624);
    GLA_GATE_PREFIX()
    float kk[16];
#pragma unroll
    for (int i = 0; i < 16; ++i) kk[i] = bf2f(P.K[(size_t)(row0 + tg * 16 + i) * 512 + h * 128 + d]);
    unsigned vw[16];
    { const int vp = tid & 127, tq = tid >> 7;
#pragma unroll
      for (int i = 0; i < 16; ++i) vw[i] = *(const unsigned*)(P.V + (size_t)(row0 + tq * 16 + i) * 1024 + h * 256 + 2 * vp); }
    __syncthreads();
    float bl[16]; float run = 0.f;
#pragma unroll
    for (int i = 0; i < 16; ++i) { float pre = gbias; const LAS f32x4* gr = (const LAS f32x4*)(glr_s + (tg * 16 + i) * 16);
#pragma unroll
        for (int j4 = 0; j4 < 4; ++j4) { const f32x4 gv = gr[j4]; pre += gv.x * wup[4 * j4] + gv.y * wup[4 * j4 + 1] + gv.z * wup[4 * j4 + 2] + gv.w * wup[4 * j4 + 3]; }
        run += logsig16(pre); bl[i] = run; }
    gsum[tg * 128 + d] = run;
    __syncthreads();
    const float g0 = gsum[d], g1 = gsum[128 + d], g2 = gsum[256 + d], g3 = gsum[384 + d];
    const float off = (tg > 0 ? g0 : 0.f) + (tg > 1 ? g1 : 0.f) + (tg > 2 ? g2 : 0.f);
    const float blast = (g0 + g1) + (g2 + g3);
    { float ks[16];
#pragma unroll
      for (int i = 0; i < 16; ++i) ks[i] = kk[i] * __expf(blast - (bl[i] + off));
      u32x4 w0, w1; w0.x = cvt_pk_bf16(ks[0], ks[1]); w0.y = cvt_pk_bf16(ks[2], ks[3]); w0.z = cvt_pk_bf16(ks[4], ks[5]); w0.w = cvt_pk_bf16(ks[6], ks[7]);
      w1.x = cvt_pk_bf16(ks[8], ks[9]); w1.y = cvt_pk_bf16(ks[10], ks[11]); w1.z = cvt_pk_bf16(ks[12], ks[13]); w1.w = cvt_pk_bf16(ks[14], ks[15]);
      *(LAS u32x4*)(kT + d * 72 + tg * 16) = w0; *(LAS u32x4*)(kT + d * 72 + tg * 16 + 8) = w1; }
    if (tg == 0) P.DEC[(size_t)item * 128 + d] = __expf(blast);
    { const int vp = tid & 127, tq = tid >> 7;
      u32x4 l0, l1, h0, h1;
#define PKLO(a, b) (((a) & 0xffffu) | ((b) << 16))
#define PKHI(a, b) (((a) >> 16) | ((b) & 0xffff0000u))
      l0.x = PKLO(vw[0], vw[1]); l0.y = PKLO(vw[2], vw[3]); l0.z = PKLO(vw[4], vw[5]); l0.w = PKLO(vw[6], vw[7]);
      l1.x = PKLO(vw[8], vw[9]); l1.y = PKLO(vw[10], vw[11]); l1.z = PKLO(vw[12], vw[13]); l1.w = PKLO(vw[14], vw[15]);
      h0.x = PKHI(vw[0], vw[1]); h0.y = PKHI(vw[2], vw[3]); h0.z = PKHI(vw[4], vw[5]); h0.w = PKHI(vw[6], vw[7]);
      h1.x = PKHI(vw[8], vw[9]); h1.y = PKHI(vw[10], vw[11]); h1.z = PKHI(vw[12], vw[13]); h1.w = PKHI(vw[14], vw[15]);
      *(LAS u32x4*)(vT + (2 * vp) * 72 + tq * 16) = l0; *(LAS u32x4*)(vT + (2 * vp) * 72 + tq * 16 + 8) = l1;
      *(LAS u32x4*)(vT + (2 * vp + 1) * 72 + tq * 16) = h0; *(LAS u32x4*)(vT + (2 * vp + 1) * 72 + tq * 16 + 8) = h1; }
    __syncthreads();
    { const int w = tid >> 6, lane = tid & 63, fr = lane & 15, fq = lane >> 4;
      bf16x8 vf[2][2];
#pragma unroll
      for (int vt = 0; vt < 2; ++vt)
#pragma unroll
          for (int ks = 0; ks < 2; ++ks) vf[vt][ks] = *(const LAS bf16x8*)(vT + ((2 * w + vt) * 16 + fr) * 72 + ks * 32 + fq * 8);
      bf16* kvb = P.KV + (size_t)item * (256 * 128);
#pragma unroll
      for (int dt = 0; dt < 8; ++dt) {
          const bf16x8 k0 = *(const LAS bf16x8*)(kT + (dt * 16 + fr) * 72 + fq * 8), k1 = *(const LAS bf16x8*)(kT + (dt * 16 + fr) * 72 + 32 + fq * 8);
#pragma unroll
          for (int vt = 0; vt < 2; ++vt) { f32x4 acc = {0.f, 0.f, 0.f, 0.f};
              acc = MFMA16(k0, vf[vt][0], acc); acc = MFMA16(k1, vf[vt][1], acc);
              u32x2 o; o.x = cvt_pk_bf16(acc[0], acc[1]); o.y = cvt_pk_bf16(acc[2], acc[3]);
              *(u32x2*)(kvb + (size_t)((2 * w + vt) * 16 + fr) * 128 + dt * 16 + fq * 4) = o; } } }
    __syncthreads();
}

__device__ __forceinline__ void gla_c_item(LAS unsigned char* lds, const GlaPtrs& P, int item, int tid) {
    const int bh = item >> 6, n = item & 63, b = bh >> 2, h = bh & 3, row0 = b * SEQ + n * 64;
    LAS float* glr_s = (LAS float*)lds;
    LAS float* gsum = (LAS float*)(lds + 4096);
    LAS float* ss_s = (LAS float*)(lds + 6144);
    LAS bf16* qi = (LAS bf16*)(lds + 8192);
    LAS bf16* qr = (LAS bf16*)(lds + 25600);
    LAS bf16* kr = (LAS bf16*)(lds + 43008);
    LAS bf16* vT = (LAS bf16*)(lds + 60416);
    LAS bf16* sc = (LAS bf16*)(lds + 97280);
    GLA_GATE_PREFIX()
    float qq[16], kk[16];
#pragma unroll
    for (int i = 0; i < 16; ++i) { const size_t o = (size_t)(row0 + tg * 16 + i) * 512 + h * 128 + d; qq[i] = bf2f(P.Q[o]); kk[i] = bf2f(P.K[o]); }
    unsigned vw[16];
    { const int vp = tid & 127, tq = tid >> 7;
#pragma unroll
      for (int i = 0; i < 16; ++i) vw[i] = *(const unsigned*)(P.V + (size_t)(row0 + tq * 16 + i) * 1024 + h * 256 + 2 * vp); }
    __syncthreads();
    float bl[16]; float run = 0.f;
#pragma unroll
    for (int i = 0; i < 16; ++i) { float pre = gbias; const LAS f32x4* gr = (const LAS f32x4*)(glr_s + (tg * 16 + i) * 16);
#pragma unroll
        for (int j4 = 0; j4 < 4; ++j4) { const f32x4 gv = gr[j4]; pre += gv.x * wup[4 * j4] + gv.y * wup[4 * j4 + 1] + gv.z * wup[4 * j4 + 2] + gv.w * wup[4 * j4 + 3]; }
        run += logsig16(pre); bl[i] = run; }
    gsum[tg * 128 + d] = run;
    __syncthreads();
    { const float g0 = gsum[d], g1 = gsum[128 + d], g2 = gsum[256 + d];
      const float off = (tg > 0 ? g0 : 0.f) + (tg > 1 ? g1 : 0.f) + (tg > 2 ? g2 : 0.f);
      const float bref = g0 + g1;
#pragma unroll
      for (int i = 0; i < 16; ++i) { const float bb = bl[i] + off; const int t = tg * 16 + i;
          const float e1 = __expf(bb), e2 = __expf(bb - bref), e3 = __expf(bref - bb);
          qi[t * 136 + d] = (bf16)(cvt_pk_bf16(qq[i] * e1, 0.f) & 0xffffu);
          qr[t * 136 + d] = (bf16)(cvt_pk_bf16(qq[i] * e2, 0.f) & 0xffffu);
          kr[t * 136 + d] = (bf16)(cvt_pk_bf16(kk[i] * e3, 0.f) & 0xffffu); } }
    { const int vp = tid & 127, tq = tid >> 7;
      u32x4 l0, l1, h0, h1;
      l0.x = PKLO(vw[0], vw[1]); l0.y = PKLO(vw[2], vw[3]); l0.z = PKLO(vw[4], vw[5]); l0.w = PKLO(vw[6], vw[7]);
      l1.x = PKLO(vw[8], vw[9]); l1.y = PKLO(vw[10], vw[11]); l1.z = PKLO(vw[12], vw[13]); l1.w = PKLO(vw[14], vw[15]);
      h0.x = PKHI(vw[0], vw[1]); h0.y = PKHI(vw[2], vw[3]); h0.z = PKHI(vw[4], vw[5]); h0.w = PKHI(vw[6], vw[7]);
      h1.x = PKHI(vw[8], vw[9]); h1.y = PKHI(vw[10], vw[11]); h1.z = PKHI(vw[12], vw[13]); h1.w = PKHI(vw[14], vw[15]);
      *(LAS u32x4*)(vT + (2 * vp) * 72 + tq * 16) = l0; *(LAS u32x4*)(vT + (2 * vp) * 72 + tq * 16 + 8) = l1;
      *(LAS u32x4*)(vT + (2 * vp + 1) * 72 + tq * 16) = h0; *(LAS u32x4*)(vT + (2 * vp + 1) * 72 + tq * 16 + 8) = h1; }
    __syncthreads();
    const int w = tid >> 6, lane = tid & 63, fr = lane & 15, fq = lane >> 4;
    { const int it = w >> 1;
#pragma unroll
      for (int jj = 0; jj < 2; ++jj) { const int jt = 2 * (w & 1) + jj; f32x4 acc = {0.f, 0.f, 0.f, 0.f};
#pragma unroll
          for (int ks = 0; ks < 4; ++ks) { const bf16x8 x = *(const LAS bf16x8*)(kr + (jt * 16 + fr) * 136 + ks * 32 + fq * 8), y = *(const LAS bf16x8*)(qr + (it * 16 + fr) * 136 + ks * 32 + fq * 8);
              acc = MFMA16(x, y, acc); }
          const int i = it * 16 + fr, j0 = jt * 16 + fq * 4;
          u32x2 o; o.x = cvt_pk_bf16(j0 <= i ? acc[0] : 0.f, j0 + 1 <= i ? acc[1] : 0.f); o.y = cvt_pk_bf16(j0 + 2 <= i ? acc[2] : 0.f, j0 + 3 <= i ? acc[3] : 0.f);
          *(LAS u32x2*)(sc + i * 72 + j0) = o; } }
    __syncthreads();
    f32x4 acc[4][2];
    { const bf16* Sb = P.KV + (size_t)item * (256 * 128);
#pragma unroll
      for (int vt = 0; vt < 2; ++vt) { const int v0 = (2 * w + vt) * 16;
          bf16x8 xv[2], xs[4];
#pragma unroll
          for (int ks = 0; ks < 2; ++ks) xv[ks] = *(const LAS bf16x8*)(vT + (v0 + fr) * 72 + ks * 32 + fq * 8);
#pragma unroll
          for (int ks = 0; ks < 4; ++ks) xs[ks] = *(const bf16x8*)(Sb + (size_t)(v0 + fr) * 128 + ks * 32 + fq * 8);
#pragma unroll
          for (int it = 0; it < 4; ++it) { f32x4 a = {0.f, 0.f, 0.f, 0.f};
#pragma unroll
              for (int ks = 0; ks < 2; ++ks) { const bf16x8 y = *(const LAS bf16x8*)(sc + (it * 16 + fr) * 72 + ks * 32 + fq * 8); a = MFMA16(xv[ks], y, a); }
#pragma unroll
              for (int ks = 0; ks < 4; ++ks) { const bf16x8 y = *(const LAS bf16x8*)(qi + (it * 16 + fr) * 136 + ks * 32 + fq * 8); a = MFMA16(xs[ks], y, a); }
              acc[it][vt] = a; } } }
#pragma unroll
    for (int it = 0; it < 4; ++it) { float p = 0.f;
#pragma unroll
        for (int vt = 0; vt < 2; ++vt) p += (acc[it][vt][0] * acc[it][vt][0] + acc[it][vt][1] * acc[it][vt][1]) + (acc[it][vt][2] * acc[it][vt][2] + acc[it][vt][3] * acc[it][vt][3]);
        p += __shfl_xor(p, 16); p += __shfl_xor(p, 32);
        if (fq == 0) ss_s[w * 64 + it * 16 + fr] = p; }
    __syncthreads();
#pragma unroll
    for (int it = 0; it < 4; ++it) { float tot = 0.f;
#pragma unroll
        for (int ww = 0; ww < 8; ++ww) tot += ss_s[ww * 64 + it * 16 + fr];
        const float rinv = rsqrtf(tot * (1.f / 256.f) + EPS);
#pragma unroll
        for (int vt = 0; vt < 2; ++vt) { const int col = h * 256 + (2 * w + vt) * 16 + fq * 4; bf16* p = P.RY + (size_t)(row0 + it * 16 + fr) * 1024 + col;
            const u32x2 rw = *(const u32x2*)p; const f32x4 gn = *(const f32x4*)(P.gnorm + col); const f32x4 a = acc[it][vt];
            u32x2 o; o.x = cvt_pk_bf16(a[0] * rinv * gn[0] * bflo(rw.x), a[1] * rinv * gn[1] * bfhi(rw.x)); o.y = cvt_pk_bf16(a[2] * rinv * gn[2] * bflo(rw.y), a[3] * rinv * gn[3] * bfhi(rw.y));
            *(u32x2*)p = o; } }
    __syncthreads();
}

__device__ __forceinline__ void gla_scan(bf16* KV, const float* DEC, int gtid, int gthreads) {
    for (int e = gtid; e < 16 * 256 * 32; e += gthreads) { const int bh = e >> 13, rem = e & 8191, v = rem >> 5, d4 = rem & 31;
        bf16* base = KV + ((size_t)(bh * 64) * 256 + v) * 128 + d4 * 4; const float* dc = DEC + (size_t)(bh * 64) * 128 + d4 * 4;
        f32x4 S = {0.f, 0.f, 0.f, 0.f};
        for (int nb = 0; nb < 8; ++nb) { u32x2 kv[8]; f32x4 dv[8];
#pragma unroll
            for (int u = 0; u < 8; ++u) { kv[u] = *(const u32x2*)(base + (size_t)(nb * 8 + u) * 32768); dv[u] = *(const f32x4*)(dc + (nb * 8 + u) * 128); }
#pragma unroll
            for (int u = 0; u < 8; ++u) { u32x2 o; o.x = cvt_pk_bf16(S[0], S[1]); o.y = cvt_pk_bf16(S[2], S[3]); *(u32x2*)(base + (size_t)(nb * 8 + u) * 32768) = o;
                const f32x4 k4 = {bflo(kv[u].x), bfhi(kv[u].x), bflo(kv[u].y), bfhi(kv[u].y)}; S = dv[u] * S + k4; } } }
}
__device__ __forceinline__ void conv_pass(bf16* CB, const bf16* Pp, const float* cw, int gtid, int gthreads) {
    for (int e = gtid; e < M * 128; e += gthreads) { const int row = e >> 7, c = (e & 127) * 8, s = row & (SEQ - 1);
        const u32x4 z = {0u, 0u, 0u, 0u};
        const u32x4 cbw = *(const u32x4*)(CB + (size_t)row * 1024 + c), p0 = *(const u32x4*)(Pp + (size_t)row * 1024 + c);
        const u32x4 p1 = s >= 1 ? *(const u32x4*)(Pp + (size_t)(row - 1) * 1024 + c) : z, p2 = s >= 2 ? *(const u32x4*)(Pp + (size_t)(row - 2) * 1024 + c) : z;
        f32x4 a0, a1, b0, b1, c0, c1, d0, d1; pg8::unpack8(cbw, a0, a1); pg8::unpack8(p0, b0, b1); pg8::unpack8(p1, c0, c1); pg8::unpack8(p2, d0, d1);
        const f32x4 w00 = *(const f32x4*)(cw + c), w01 = *(const f32x4*)(cw + c + 4), w10 = *(const f32x4*)(cw + 1024 + c), w11 = *(const f32x4*)(cw + 1024 + c + 4), w20 = *(const f32x4*)(cw + 2048 + c), w21 = *(const f32x4*)(cw + 2048 + c + 4);
        const f32x4 y0 = a0 * (w00 * d0 + w10 * c0 + w20 * b0), y1 = a1 * (w01 * d1 + w11 * c1 + w21 * b1);
        *(u32x4*)(CB + (size_t)row * 1024 + c) = pg8::pack8(y0, y1); }
}

#define XB_TMO      128
#define XB_XCNT(j)  (256  + 64 * (j))
#define XB_XSUB(j)  (1280 + 64 * (j))
#define XB_XGEN(j)  (2304 + 64 * (j))
#define XB_TOP      3328
#define XB_TOPGEN   3392
#define XCD_BAR_WORDS 3456
#define XB_SPIN_CAP (1u << 18)

__device__ __forceinline__ unsigned xb_ld(unsigned* p)              { return __hip_atomic_load(p, __ATOMIC_RELAXED, __HIP_MEMORY_SCOPE_AGENT); }
__device__ __forceinline__ unsigned xb_add(unsigned* p, unsigned v) { return __hip_atomic_fetch_add(p, v, __ATOMIC_RELAXED, __HIP_MEMORY_SCOPE_AGENT); }
__device__ __forceinline__ unsigned xb_xcc_id() { return (unsigned)__builtin_amdgcn_s_getreg((3 << 11) | 20) & 0xFu; }
#define XB_SPIN(cond, bar) do { unsigned _sp = 0; while (cond) { __builtin_amdgcn_s_sleep(1); \
    if ((++_sp & 255u) == 0u) { if (xb_ld(&(bar)[XB_TMO])) break; if (_sp > XB_SPIN_CAP) { atomicAdd(&(bar)[XB_TMO], 1u); break; } } } } while (0)

struct XcdBarrier {
    unsigned* bar; unsigned x;
    volatile LAS unsigned* st;
};

__device__ __forceinline__ XcdBarrier xcd_barrier_post(unsigned* bar, volatile LAS unsigned* st) {
    XcdBarrier b; b.bar = bar; b.x = xb_xcc_id(); b.st = st;
    if (threadIdx.x == 0) (void)xb_add(&bar[XB_XCNT(b.x)], 1u);
    return b;
}
__device__ __forceinline__ void xcd_barrier_complete(unsigned* bar, unsigned x, unsigned& nloc, unsigned& nx) {
    const unsigned G = gridDim.x * gridDim.y * gridDim.z;
    unsigned sum, cnt, mine, sp = 0u;
    for (;;) {
        sum = 0u; cnt = 0u; mine = 0u;
#pragma unroll
        for (unsigned j = 0; j < 16; ++j) { const unsigned c = xb_ld(&bar[XB_XCNT(j)]); sum += c; cnt += (c > 0u) ? 1u : 0u; mine = (j == x) ? c : mine; }
        if (sum == G) break;
        __builtin_amdgcn_s_sleep(1);
        if ((++sp & 255u) == 0u) { if (xb_ld(&bar[XB_TMO])) break; if (sp > XB_SPIN_CAP) { atomicAdd(&bar[XB_TMO], 1u); break; } }
    }
    nloc = mine > 0u ? mine : 1u; nx = cnt > 0u ? cnt : 1u;
}

__device__ __forceinline__ void xcd_barrier(const XcdBarrier& b) {
    asm volatile("s_waitcnt vmcnt(0)" ::: "memory");
    __syncthreads();
    if (threadIdx.x == 0) {
        unsigned* bar = b.bar;
        __builtin_amdgcn_s_waitcnt(0);
        unsigned nloc = b.st[0], nx = b.st[1];
        if (nloc == 0u) { xcd_barrier_complete(bar, b.x, nloc, nx); b.st[0] = nloc; b.st[1] = nx; }
        const unsigned old = xb_add(&bar[XB_XSUB(b.x)], 1u);
        const unsigned gen = old / nloc;
        if (old + 1u == (gen + 1u) * nloc) {
            __builtin_amdgcn_fence(__ATOMIC_RELEASE, "agent");
            asm volatile("s_waitcnt vmcnt(0)" ::: "memory");
            const unsigned og = xb_add(&bar[XB_TOP], 1u);
            const unsigned tg = og / nx;
            if (og + 1u == (tg + 1u) * nx) xb_add(&bar[XB_TOPGEN], 1u);
            else XB_SPIN(xb_ld(&bar[XB_TOPGEN]) == tg, bar);
            __builtin_amdgcn_fence(__ATOMIC_ACQUIRE, "agent");
            xb_add(&bar[XB_XGEN(b.x)], 1u);
            asm volatile("s_waitcnt vmcnt(0)" ::: "memory");
        } else {
            XB_SPIN(xb_ld(&bar[XB_XGEN(b.x)]) == gen, bar);
            __builtin_amdgcn_fence(__ATOMIC_ACQUIRE, "agent");
            asm volatile("s_waitcnt vmcnt(0)" ::: "memory");
        }
    }
    __syncthreads();
}

struct Args { const float* in[17]; float* out; unsigned char* ws; int ph_lo, ph_hi; };
constexpr int NPHASE = 14;
#ifndef MK_SPLIT
#define MK_SPLIT 0
#endif

__global__ void __launch_bounds__(NT, 2) mega_fwd(Args args) {
    extern __shared__ __attribute__((aligned(16))) unsigned char lds_raw[];
    LAS unsigned char* lds = (LAS unsigned char*)lds_raw;
#define FRESH_TID() int tid = threadIdx.x; asm volatile("" : "+v"(tid)); const int lane = tid & 63; const int wave = __builtin_amdgcn_readfirstlane(tid >> 6); \
    const int gw = bx * NWAVES + wave, ngw = G * NWAVES, gtid = bx * NT + tid, gthreads = G * NT; (void)lane; (void)gw; (void)ngw; (void)gtid; (void)gthreads;
    const int G = gridDim.x, bx = blockIdx.x;
    unsigned char* ws = args.ws;
    const float* x = args.in[0]; float* out = args.out;
    bf16* Wgu = (bf16*)(ws + WS_WGU); bf16* Wd = (bf16*)(ws + WS_WD); bf16* Win = (bf16*)(ws + WS_WIN); bf16* Wglr = (bf16*)(ws + WS_WGLR);
    bf16* Woc = (bf16*)(ws + WS_WOC); bf16* Wog = (bf16*)(ws + WS_WOG); bf16* Wo = (bf16*)(ws + WS_WO);
    bf16* H = (bf16*)(ws + WS_H); bf16* ACT = (bf16*)(ws + WS_ACT);
    float* GLR = (float*)(ws + WS_GLR);
    const int lo = args.ph_lo, hi = args.ph_hi;
    volatile LAS unsigned* xst = (volatile LAS unsigned*)(lds + 131072 + 512);
    if (threadIdx.x < 2) xst[threadIdx.x] = 0u;
    __syncthreads();
    XcdBarrier xbar; xbar.bar = (unsigned*)(ws + WS_CTL) + 1024; xbar.x = 0; xbar.st = xst;
    if (!MK_SPLIT) xbar = xcd_barrier_post((unsigned*)(ws + WS_CTL) + 1024, xst);
#define IN(k) (lo <= (k) && (k) < hi)
#ifndef REP_PHASE
#define REP_PHASE -1
#endif
#define REPS(k) for (int rep_ = 0; rep_ < ((k) == REP_PHASE ? 2 : 1); ++rep_)
#if MK_SPLIT
#define SEAM(k) do { } while (0)
#else
#define SEAM(k) do { if (IN(k) && IN((k) + 1)) { if ((k) == 0) { asm volatile("s_waitcnt vmcnt(0) lgkmcnt(0)" ::: "memory"); cg::this_grid().sync(); } else xcd_barrier(xbar); } } while (0)
#endif
#define RTAB ((const LAS float*)(lds + 131072 + 1024))
#define FILL_RTAB(Nn, SSp) do { pg8::StaticOrder S_; S_.init(M, (Nn), G, bx); pg8::Unit u_; \
        for (int i_ = threadIdx.x; i_ < 8 * 256; i_ += NT) { if (S_.next(i_ >> 8, u_)) ((LAS float*)(lds + 131072 + 1024))[i_] = pg8::row_rinv((SSp), u_.pm * 256 + (i_ & 255)); } \
        __syncthreads(); } while (0)
#define RUN_GEMM(EPI, Ap, Bp, Nn, Kk, Eobj) do { pg8::Gemm g_{(const pg8::bf16_t*)(Ap), (const pg8::bf16_t*)(Bp), M, (Nn), (Kk)}; pg8::StaticOrder S_; S_.init(M, (Nn), G, bx); \
        pg8::gemm_phase<EPI, pg8::StaticOrder, true, true>(lds, g_, S_, Eobj); } while (0)

    float* SS1 = (float*)(ws + WS_SS1); float* SS2 = (float*)(ws + WS_SS2); float* SS3 = (float*)(ws + WS_SS3); float* SS4 = (float*)(ws + WS_SS4);
    bf16* HB3 = (bf16*)(ws + WS_HB3);
    if (IN(0)) { FRESH_TID()
        LAS float* scr = (LAS float*)(lds + wave * 16384);
        tr_matrix<1>(args.in[2], 2 * FF, D, 2 * FF, Wgu, scr, gw, ngw, lane, args.in[1]);
        tr_matrix<0>(args.in[3], D, FF, D, Wd, scr, gw, ngw, lane, nullptr);
        tr_matrix<2>(args.in[5], INC, D, 8192, Win, scr, gw, ngw, lane, args.in[4]);
        tr_matrix<0>(args.in[10], D, D, D, Woc, scr, gw, ngw, lane, nullptr);
        tr_matrix<0>(args.in[11], D, D, D, Wog, scr, gw, ngw, lane, nullptr);
        tr_matrix<0>(args.in[12], D, D, D, Wo, scr, gw, ngw, lane, nullptr);
        for (int e = gtid; e < 16 * D; e += gthreads) { const int nn = e >> 10, k = e & 1023; Wglr[e] = (bf16)(cvt_pk_bf16(args.in[5][(size_t)k * INC + 5120 + nn] * args.in[4][k], 0.f) & 0xffffu); }
        for (int m = gw; m < M; m += ngw) cvt_row_bf16(x + (size_t)m * D, H + (size_t)m * D, SS1 + (size_t)m * 16, lane);
    }
    SEAM(0);
    if (IN(1)) { FILL_RTAB(2 * FF, SS1); pg8::EpiSwiglu E{(pg8::bf16_t*)ACT, FF, RTAB}; RUN_GEMM(pg8::EpiSwiglu, H, Wgu, 2 * FF, D, E); }
    SEAM(1);
    if (IN(2)) { pg8::EpiRes<true> E{x, out, D, 0.5f, (pg8::bf16_t*)H, SS2}; RUN_GEMM(pg8::EpiRes<true>, ACT, Wd, D, FF, E); }
    SEAM(2);
    if (IN(3)) { { FRESH_TID() for (int r = bx * 4 + wave; wave < 4 && r < M / 16; r += G * 4) glr_16(H, Wglr, SS2, GLR, r * 16, lane); }
        pg8::EpiZa E{(pg8::bf16_t*)(ws + WS_Q), (pg8::bf16_t*)(ws + WS_K), (pg8::bf16_t*)(ws + WS_V), (pg8::bf16_t*)(ws + WS_R), RTAB}; FILL_RTAB(3072, SS2); RUN_GEMM(pg8::EpiZa, H, Win, 3072, D, E); }
    SEAM(3);
    GlaPtrs GP{GLR, args.in[7], args.in[8], args.in[9], (const bf16*)(ws + WS_Q), (const bf16*)(ws + WS_K), (const bf16*)(ws + WS_V), (bf16*)(ws + WS_R), (bf16*)(ws + WS_KV), (float*)(ws + WS_DEC)};
    if (IN(4)) { FRESH_TID() for (int it = bx; it < NITEM; it += G) gla_a_item(lds, GP, it, tid); }
    SEAM(4);
    if (IN(5)) { FRESH_TID() gla_scan((bf16*)(ws + WS_KV), (const float*)(ws + WS_DEC), gtid, gthreads);
        LAS float* scr = (LAS float*)(lds + wave * 16384);
        tr_matrix<1>(args.in[14], 2 * FF, D, 2 * FF, Wgu, scr, gw, ngw, lane, args.in[13]);
        tr_matrix<0>(args.in[15], D, FF, D, Wd, scr, gw, ngw, lane, nullptr); }
    SEAM(5);
    if (IN(6)) { FRESH_TID() for (int it = bx; it < NITEM; it += G) gla_c_item(lds, GP, it, tid); }
    SEAM(6);
    if (IN(7)) { pg8::EpiZb E{(pg8::bf16_t*)(ws + WS_CB), (pg8::bf16_t*)(ws + WS_P), (pg8::bf16_t*)(ws + WS_GA), (pg8::bf16_t*)(ws + WS_GB), RTAB}; FILL_RTAB(5120, SS2); RUN_GEMM(pg8::EpiZb, H, Win + (size_t)3072 * D, 5120, D, E); }
    SEAM(7);
    if (IN(8)) { FRESH_TID() conv_pass((bf16*)(ws + WS_CB), (const bf16*)(ws + WS_P), args.in[6], gtid, gthreads); }
    SEAM(8);
    if (IN(9)) {
        { pg8::EpiGate<0> E{(const pg8::bf16_t*)(ws + WS_GA), nullptr, (pg8::bf16_t*)(ws + WS_P)}; RUN_GEMM(pg8::EpiGate<0>, ws + WS_CB, Woc, D, D, E); }
        { pg8::EpiGate<1> E{(const pg8::bf16_t*)(ws + WS_GB), (const pg8::bf16_t*)(ws + WS_P), (pg8::bf16_t*)(ws + WS_H)}; RUN_GEMM(pg8::EpiGate<1>, ws + WS_R, Wog, D, D, E); }
    }
    SEAM(9);
    if (IN(10)) { pg8::EpiRes<true> E{out, out, D, 1.0f, (pg8::bf16_t*)HB3, SS3}; RUN_GEMM(pg8::EpiRes<true>, H, Wo, D, D, E); }
    SEAM(10);
    if (IN(11)) { FILL_RTAB(2 * FF, SS3); pg8::EpiSwiglu E{(pg8::bf16_t*)ACT, FF, RTAB}; RUN_GEMM(pg8::EpiSwiglu, HB3, Wgu, 2 * FF, D, E); }
    SEAM(11);
    if (IN(12)) { pg8::EpiRes<false> E{out, out, D, 0.5f, nullptr, SS4}; RUN_GEMM(pg8::EpiRes<false>, ACT, Wd, D, FF, E); }
    SEAM(12);
    if (IN(13)) { FRESH_TID() const float* gf = args.in[16];
        for (int e = gtid; e < M * 256; e += gthreads) { const int row = e >> 8, c4 = (e & 255) * 4; const float ri = pg8::row_rinv(SS4, row);
            f32x4* p = (f32x4*)(out + (size_t)row * D + c4); *p = *p * ri * *(const f32x4*)(gf + c4); } }
}

extern "C" void kernel_launch(void* const* d_in, const int* in_sizes, int n_in, void* d_out, int out_size, void* d_ws, size_t ws_size, hipStream_t stream) {
    static int grid = 0;
    if (grid == 0) {
        if (n_in != 17 || in_sizes[0] != M * D || out_size != M * D || ws_size < WS_END) { fprintf(stderr, "kernel_launch: unexpected shapes / workspace (n_in %d, ws %zu)\n", n_in, ws_size); grid = -1; return; }
        int dev = 0, cus = 0, per_cu = 0;
        hipGetDevice(&dev); hipDeviceGetAttribute(&cus, hipDeviceAttributeMultiprocessorCount, dev);
        if (hipFuncSetAttribute((const void*)mega_fwd, hipFuncAttributeMaxDynamicSharedMemorySize, LDS_BYTES) != hipSuccess) { fprintf(stderr, "kernel_launch: hipFuncSetAttribute failed\n"); grid = -1; return; }
        if (hipOccupancyMaxActiveBlocksPerMultiprocessor(&per_cu, (const void*)mega_fwd, NT, LDS_BYTES) != hipSuccess || per_cu < 1) { per_cu = 1; (void)hipGetLastError(); }
        grid = cus * per_cu;
    }
    if (grid < 0) return;
    if (hipMemsetAsync((char*)d_ws + WS_CTL, 0, CTL_ZERO_BYTES, stream) != hipSuccess) { fprintf(stderr, "kernel_launch: memset failed\n"); return; }
    Args a{};
    for (int i = 0; i < 17; ++i) a.in[i] = (const float*)d_in[i];
    a.out = (float*)d_out; a.ws = (unsigned char*)d_ws;
#if MK_SPLIT
    for (int p = 0; p < NPHASE; ++p) { a.ph_lo = p; a.ph_hi = p + 1; hipLaunchKernelGGL(mega_fwd, dim3(grid), dim3(NT), LDS_BYTES, stream, a); }
#else
    a.ph_lo = 0; a.ph_hi = NPHASE;
    void* kargs[] = {&a};
    hipError_t e = hipLaunchCooperativeKernel((const void*)mega_fwd, dim3(grid), dim3(NT), kargs, LDS_BYTES, stream);
    if (e != hipSuccess) fprintf(stderr, "cooperative launch failed: %s (grid %d)\n", hipGetErrorString(e), grid);
#endif
}
```

```cpp
#include <hip/hip_runtime.h>
#include <hip/hip_cooperative_groups.h>
#include <cstdio>
#include <cstdint>
namespace cg = cooperative_groups;
namespace pg8 {
#define PG8_LAS __attribute__((address_space(3)))
typedef unsigned short bf16_t;
typedef short bf16x8 __attribute__((ext_vector_type(8)));
typedef float f32x4 __attribute__((ext_vector_type(4)));
typedef unsigned u32x4 __attribute__((ext_vector_type(4)));
constexpr int BM = 256, BK = 64, HALF = 128, HTB = HALF * BK * 2  , STAGE_BYTES = 8 * HTB, NXCD = 8, WGM = 8;

__host__ __device__ __forceinline__ int lds_byte(int r, int c) { const int st = (r >> 4) * 2 + (c >> 5), rr = r & 15, cc = c & 31, ob = rr * 64 + cc * 2; return st * 1024 + (ob ^ (((ob >> 9) & 1) << 5)); }
__host__ __device__ __forceinline__ void stage_rc(int b, int& R, int& C) { const int st = b / 1024, sb = b % 1024, swz = sb ^ (((sb >> 9) & 1) << 5); R = (st >> 1) * 16 + swz / 64; C = (st & 1) * 32 + (swz % 64) / 2; }
__host__ __device__ __forceinline__ int perm32(int rho) { const int n = rho >> 4, i = rho & 15; return 8 * (i >> 2) + 4 * n + (i & 3); }

struct Unit { int pm, pn; };
struct Gemm { const bf16_t* A; const bf16_t* Bt; int M, N, K; };

struct StaticOrder {
    int nM, nN, nwg, G, c;
    __host__ __device__ void init(int M, int N, int G_, int c_) { nM = M / BM; nN = N / BM; nwg = nM * nN; G = G_; c = c_; }
    __host__ __device__ bool next(int i, Unit& u) const {
        const long L = (long)i * G + c; if (L >= nwg) return false;
        int wgid = (int)L; { const int q = nwg / NXCD, r = nwg % NXCD, xcd = wgid % NXCD, off = wgid / NXCD; wgid = (xcd < r ? xcd * (q + 1) : r * (q + 1) + (xcd - r) * q) + off; }
        const int nig = WGM * nN, gid = wgid / nig, fm = gid * WGM, gsz = (nM - fm) < WGM ? (nM - fm) : WGM;
        u.pm = fm + ((wgid % nig) % gsz); u.pn = (wgid % nig) / gsz; return true;
    }
    __device__ __forceinline__ void a_ready(const Unit&) const {}
    __device__ __forceinline__ void done(const Unit&) const {}
};
typedef float f32x2_cv __attribute__((ext_vector_type(2))); typedef __bf16 bf16x2_cv __attribute__((ext_vector_type(2)));
__device__ __forceinline__ unsigned cvt_pk_bf16(float lo, float hi) { const f32x2_cv v = {lo, hi}; const bf16x2_cv b = __builtin_convertvector(v, bf16x2_cv); return __builtin_bit_cast(unsigned, b); }
typedef float f32x2 __attribute__((ext_vector_type(2)));
typedef unsigned u32x2 __attribute__((ext_vector_type(2)));
__device__ __forceinline__ float bflo(unsigned w) { return __uint_as_float(w << 16); }
__device__ __forceinline__ float bfhi(unsigned w) { return __uint_as_float(w & 0xffff0000u); }
__device__ __forceinline__ float sigmoid_f(float x) { return __builtin_amdgcn_rcpf(1.0f + __builtin_amdgcn_exp2f(-1.4426950408889634f * x)); }
__device__ __forceinline__ float silu_f(float x) { return x * sigmoid_f(x); }
__device__ __forceinline__ u32x4 pack8(const f32x4& v0, const f32x4& v1) { u32x4 w; w.x = cvt_pk_bf16(v0[0], v0[1]); w.y = cvt_pk_bf16(v0[2], v0[3]); w.z = cvt_pk_bf16(v1[0], v1[1]); w.w = cvt_pk_bf16(v1[2], v1[3]); return w; }
__device__ __forceinline__ void unpack8(const u32x4& w, f32x4& v0, f32x4& v1) { v0 = (f32x4){bflo(w.x), bfhi(w.x), bflo(w.y), bfhi(w.y)}; v1 = (f32x4){bflo(w.z), bfhi(w.z), bflo(w.w), bfhi(w.w)}; }

__device__ __forceinline__ float row_rinv(const float* ss, int row) { const f32x4* p = (const f32x4*)(ss + (size_t)row * 16); const f32x4 a = p[0], b = p[1], c = p[2], d = p[3];
    const f32x4 t = (a + b) + (c + d); return rsqrtf(((t[0] + t[1]) + (t[2] + t[3])) * (1.0f / 1024.0f) + 1e-6f); }
typedef const PG8_LAS float* rtab_t;
#define PIN4(a,b,c,d) asm volatile("" : "+v"(a), "+v"(b), "+v"(c), "+v"(d))
struct EpiSwiglu {
    static constexpr bool PERM = true, AFTER_DRAIN = false;
    bf16_t* O; int ldc; rtab_t rt;
    __device__ __forceinline__ void operator()(const f32x4 (&acc)[2][2][4][2], const Unit& u, int wr, int wc, int fr, int fq, int ui) const {
        const int row0 = u.pm * BM + wr * 64 + fr, col0 = u.pn * HALF + wc * 32 + 8 * fq;
#pragma unroll
        for (int ai = 0; ai < 2; ++ai)
#pragma unroll
            for (int m = 0; m < 4; ++m) { const int row = row0 + ai * HALF + m * 16; bf16_t* rowp = O + (size_t)row * ldc + col0; const float ri = rt[ui * 256 + wr * 64 + fr + ai * HALF + m * 16];
                f32x4 g0 = acc[ai][0][m][0], g1 = acc[ai][0][m][1], u0 = acc[ai][1][m][0], u1 = acc[ai][1][m][1]; PIN4(g0, g1, u0, u1);
                g0 = g0 * ri; g1 = g1 * ri; u0 = u0 * ri; u1 = u1 * ri;
                f32x4 v0, v1;
#pragma unroll
                for (int j = 0; j < 4; ++j) { v0[j] = silu_f(g0[j]) * u0[j]; v1[j] = silu_f(g1[j]) * u1[j]; }
                *(u32x4*)rowp = pack8(v0, v1); asm volatile("" ::: "memory"); }
    }
};
template <bool WITH_HB> struct EpiRes {
    static constexpr bool PERM = false, AFTER_DRAIN = false;
    const float* base; float* out; int ldc; float alpha; bf16_t* HB; float* ss;
    __device__ __forceinline__ void operator()(const f32x4 (&acc)[2][2][4][2], const Unit& u, int wr, int wc, int fr, int fq, int ui) const {
        const int row0 = u.pm * BM + wr * 64 + fr, col0 = u.pn * BM + wc * 32 + 4 * fq;
#pragma unroll
        for (int ai = 0; ai < 2; ++ai)
#pragma unroll
            for (int m = 0; m < 4; ++m) { const int row = row0 + ai * HALF + m * 16; const size_t off = (size_t)row * ldc + col0; float p = 0.f;
#pragma unroll
                for (int bj = 0; bj < 2; ++bj)
#pragma unroll
                    for (int n = 0; n < 2; ++n) { const f32x4 b = *(const f32x4*)(base + off + bj * HALF + n * 16); const f32x4 o = b + alpha * acc[ai][bj][m][n];
                        *(f32x4*)(out + off + bj * HALF + n * 16) = o; p += (o[0] * o[0] + o[1] * o[1]) + (o[2] * o[2] + o[3] * o[3]);
                        if (WITH_HB) { u32x2 w; w.x = cvt_pk_bf16(o[0], o[1]); w.y = cvt_pk_bf16(o[2], o[3]); *(u32x2*)(HB + off + bj * HALF + n * 16) = w; } }
                p += __shfl_xor(p, 16); p += __shfl_xor(p, 32);
                if (fq == 0) ss[(size_t)row * 16 + u.pn * 4 + wc] = p;
                asm volatile("" ::: "memory"); }
    }
};
template <int ACT> __device__ __forceinline__ void store_tile_bf16(const f32x4 (&acc)[2][2][4][2], bf16_t* O, int ldc, int row0, int colt, int wc, int fq, float scale, rtab_t rt) {
    const int col0 = colt + wc * 32 + 8 * fq;
#pragma unroll
    for (int ai = 0; ai < 2; ++ai)
#pragma unroll
        for (int m = 0; m < 4; ++m) { const int row = row0 + ai * HALF + m * 16; bf16_t* rowp = O + (size_t)row * ldc + col0; const float ri = rt[(row & 255)] * scale;
#pragma unroll
            for (int bj = 0; bj < 2; ++bj) { f32x4 v0 = acc[ai][bj][m][0], v1 = acc[ai][bj][m][1]; asm volatile("" : "+v"(v0), "+v"(v1));
                v0 = v0 * ri; v1 = v1 * ri;
                if (ACT == 1) {
#pragma unroll
                    for (int j = 0; j < 4; ++j) { v0[j] = silu_f(v0[j]); v1[j] = silu_f(v1[j]); } }
                if (ACT == 2) {
#pragma unroll
                    for (int j = 0; j < 4; ++j) { v0[j] = sigmoid_f(v0[j]); v1[j] = sigmoid_f(v1[j]); } }
                *(u32x4*)(rowp + bj * HALF) = pack8(v0, v1); asm volatile("" ::: "memory"); } }
}
struct EpiZa {
    static constexpr bool PERM = true, AFTER_DRAIN = false;
    bf16_t *Q, *K, *V, *R; rtab_t rt;
    __device__ __forceinline__ void operator()(const f32x4 (&acc)[2][2][4][2], const Unit& u, int wr, int wc, int fr, int fq, int ui) const {
        const int row0 = u.pm * BM + wr * 64 + fr, pn = u.pn;
        if (pn < 2) store_tile_bf16<0>(acc, Q, 512, row0, pn * BM, wc, fq, 0.08838834764831845f, rt + ui * 256);
        else if (pn < 4) store_tile_bf16<0>(acc, K, 512, row0, (pn - 2) * BM, wc, fq, 1.0f, rt + ui * 256);
        else if (pn < 8) store_tile_bf16<0>(acc, V, 1024, row0, (pn - 4) * BM, wc, fq, 1.0f, rt + ui * 256);
        else store_tile_bf16<1>(acc, R, 1024, row0, (pn - 8) * BM, wc, fq, 1.0f, rt + ui * 256);
    }
};
struct EpiZb {
    static constexpr bool PERM = true, AFTER_DRAIN = false;
    bf16_t *CB, *P, *GA, *GB; rtab_t rt;
    __device__ __forceinline__ void operator()(const f32x4 (&acc)[2][2][4][2], const Unit& u, int wr, int wc, int fr, int fq, int ui) const {
        const int row0 = u.pm * BM + wr * 64 + fr, pn = u.pn;
        if (pn < 4) store_tile_bf16<0>(acc, CB, 1024, row0, pn * BM, wc, fq, 1.0f, rt + ui * 256);
        else if (pn < 12) {
            const int col0 = (pn - 4) * HALF + wc * 32 + 8 * fq;
#pragma unroll
            for (int ai = 0; ai < 2; ++ai)
#pragma unroll
                for (int m = 0; m < 4; ++m) { const int row = row0 + ai * HALF + m * 16; bf16_t* rowp = P + (size_t)row * 1024 + col0; const float ri = rt[ui * 256 + (row & 255)], ri2 = ri * ri;
                    *(u32x4*)rowp = pack8(acc[ai][0][m][0] * acc[ai][1][m][0] * ri2, acc[ai][0][m][1] * acc[ai][1][m][1] * ri2); }
        }
        else if (pn < 16) store_tile_bf16<2>(acc, GA, 1024, row0, (pn - 12) * BM, wc, fq, 1.0f, rt + ui * 256);
        else store_tile_bf16<2>(acc, GB, 1024, row0, (pn - 16) * BM, wc, fq, 1.0f, rt + ui * 256);
    }
};
template <int MODE> struct EpiGate {
    static constexpr bool PERM = true, AFTER_DRAIN = false;
    const bf16_t* G; const bf16_t* T; bf16_t* O;
    __device__ __forceinline__ void operator()(const f32x4 (&acc)[2][2][4][2], const Unit& u, int wr, int wc, int fr, int fq, int ui) const {
        const int row0 = u.pm * BM + wr * 64 + fr, col0 = u.pn * BM + wc * 32 + 8 * fq;
#pragma unroll
        for (int ai = 0; ai < 2; ++ai)
#pragma unroll
            for (int m = 0; m < 4; ++m) { const size_t off = (size_t)(row0 + ai * HALF + m * 16) * 1024 + col0;
#pragma unroll
                for (int bj = 0; bj < 2; ++bj) {
                    f32x4 g0, g1; unpack8(*(const u32x4*)(G + off + bj * HALF), g0, g1);
                    f32x4 v0 = g0 * acc[ai][bj][m][0], v1 = g1 * acc[ai][bj][m][1];
                    if (MODE == 1) { f32x4 t0, t1; unpack8(*(const u32x4*)(T + off + bj * HALF), t0, t1); v0 = v0 + t0; v1 = v1 + t1; }
                    *(u32x4*)(O + off + bj * HALF) = pack8(v0, v1); }
                asm volatile("" ::: "memory"); }
    }
};

template <class Epi, class Sched, bool ALIGN_EPI = false, bool SP2 = false>
__device__ __forceinline__ void gemm_phase(PG8_LAS unsigned char* lds, const Gemm g, const Sched& S, const Epi& E) {
    const int tid = threadIdx.x, wid = __builtin_amdgcn_readfirstlane(tid >> 6), lane = tid & 63, wr = wid >> 2, wc = wid & 3, fr = lane & 15, fq = lane >> 4;
    const int K = g.K, nt = K / BK;
    unsigned voffA[2], voffB[2];
#pragma unroll
    for (int i = 0; i < 2; ++i) { int R, C; stage_rc(tid * 16 + i * 8192, R, C); const int Rb = Epi::PERM ? ((R & ~31) + perm32(R & 31)) : R;
        voffA[i] = (unsigned)(R * K + C) * 2u; voffB[i] = (unsigned)(Rb * K + C) * 2u; }
    const size_t kstep = (size_t)(BK * 2);
    const size_t hstep = (size_t)HALF * K * 2;
    const size_t tstep = 2 * hstep;
    const unsigned ldsw = (unsigned)wid * 1024u;
    const int aoff = lds_byte(wr * 64 + fr, fq * 8), boff = lds_byte(wc * 32 + fr, fq * 8);
#define PG8_SA(b, h) (((b) * 2 + (h)) * HTB)
#define PG8_SB(b, h) ((4 + (b) * 2 + (h)) * HTB)
#define PG8_STAGE(bufoff, gbase, voff) do { _Pragma("unroll") for (int _i = 0; _i < 2; ++_i) \
        __builtin_amdgcn_global_load_lds((const unsigned*)((const char*)(gbase) + (voff)[_i]), (PG8_LAS unsigned*)(lds + (bufoff) + ldsw + _i * 8192), 16, 0, 0); } while (0)
#define PG8_LDA(dst, b, h) do { _Pragma("unroll") for (int m = 0; m < 4; ++m) _Pragma("unroll") for (int k = 0; k < 2; ++k) dst[m][k] = *(const PG8_LAS bf16x8*)(lds + PG8_SA(b, h) + aoff + m * 2048 + k * 1024); } while (0)
#define PG8_LDB(dst, b, h) do { _Pragma("unroll") for (int n = 0; n < 2; ++n) _Pragma("unroll") for (int k = 0; k < 2; ++k) dst[n][k] = *(const PG8_LAS bf16x8*)(lds + PG8_SB(b, h) + boff + n * 2048 + k * 1024); } while (0)
#define PG8_MMA(ai, bj, At, Bt) do { __builtin_amdgcn_s_setprio(1); _Pragma("unroll") for (int m = 0; m < 4; ++m) _Pragma("unroll") for (int n = 0; n < 2; ++n) _Pragma("unroll") for (int k = 0; k < 2; ++k) \
        acc[ai][bj][m][n] = __builtin_amdgcn_mfma_f32_16x16x32_bf16(Bt[n][k], At[m][k], acc[ai][bj][m][n], 0, 0, 0); __builtin_amdgcn_s_setprio(0); } while (0)
#define PG8_WAIT_V(n) asm volatile("s_waitcnt vmcnt(" #n ")" ::: "memory")
#define PG8_WAIT_L(n) asm volatile("s_waitcnt lgkmcnt(" #n ")" ::: "memory")
#define PG8_BAR __builtin_amdgcn_s_barrier()
#define PG8_SCHED __builtin_amdgcn_sched_barrier(0)
    Unit cur, nxt; int ui = 0;
    if (!S.next(0, cur)) return;
    f32x4 acc[2][2][4][2];
#pragma unroll
    for (int a = 0; a < 2; ++a)
#pragma unroll
        for (int b = 0; b < 2; ++b)
#pragma unroll
            for (int m = 0; m < 4; ++m)
#pragma unroll
                for (int n = 0; n < 2; ++n) acc[a][b][m][n] = (f32x4){0.f, 0.f, 0.f, 0.f};
    bf16x8 At[4][2], B0[2][2], B1[2][2];
    const char* cA = (const char*)g.A + (size_t)cur.pm * tstep; const char* cB = (const char*)g.Bt + (size_t)cur.pn * tstep;
    S.a_ready(cur);
    if constexpr (SP2) {
        PG8_STAGE(PG8_SB(0, 0), cB, voffB); PG8_STAGE(PG8_SB(0, 1), cB + hstep, voffB); PG8_STAGE(PG8_SA(0, 0), cA, voffA); PG8_STAGE(PG8_SA(0, 1), cA + hstep, voffA);
        if (wr == 1) PG8_BAR;
        PG8_WAIT_V(2); PG8_BAR;
        PG8_STAGE(PG8_SB(1, 0), cB + kstep, voffB); PG8_STAGE(PG8_SA(1, 0), cA + kstep, voffA); PG8_STAGE(PG8_SB(1, 1), cB + hstep + kstep, voffB);
        PG8_WAIT_V(6); PG8_BAR;
    } else {
        PG8_STAGE(PG8_SB(0, 0), cB, voffB); PG8_STAGE(PG8_SA(0, 0), cA, voffA); PG8_STAGE(PG8_SB(0, 1), cB + hstep, voffB); PG8_STAGE(PG8_SA(0, 1), cA + hstep, voffA);
        if (wr == 1) PG8_BAR;
        PG8_WAIT_V(4); PG8_BAR;
        PG8_STAGE(PG8_SB(1, 0), cB + kstep, voffB); PG8_STAGE(PG8_SA(1, 0), cA + kstep, voffA); PG8_STAGE(PG8_SB(1, 1), cB + hstep + kstep, voffB);
        PG8_WAIT_V(6); PG8_BAR;
    }
    for (;;) {
        const bool has_next = S.next(ui + 1, nxt);
        const char* nA = has_next ? (const char*)g.A + (size_t)nxt.pm * tstep : cA; const char* nB = has_next ? (const char*)g.Bt + (size_t)nxt.pn * tstep : cB;
        for (int t = 0; t < nt; t += 2) {
            const bool last = (t == nt - 2);
            const char* a1 = cA + (size_t)(t + 1) * kstep;
            const char* a2 = last ? nA : cA + (size_t)(t + 2) * kstep; const char* b2 = last ? nB : cB + (size_t)(t + 2) * kstep;
            const char* a3 = a2 + kstep; const char* b3 = b2 + kstep;
            if (last && has_next) S.a_ready(nxt);
            if constexpr (SP2) {
            PG8_LDB(B0, 0, 0); PG8_LDB(B1, 0, 1); PG8_SCHED; PG8_LDA(At, 0, 0); PG8_STAGE(PG8_SA(1, 1), a1 + hstep, voffA);
            PG8_WAIT_V(8); PG8_WAIT_L(0); PG8_BAR; PG8_MMA(0, 0, At, B0); PG8_MMA(0, 1, At, B1); PG8_BAR; PG8_SCHED;
            PG8_LDA(At, 0, 1); PG8_STAGE(PG8_SB(0, 0), b2, voffB); PG8_STAGE(PG8_SB(0, 1), b2 + hstep, voffB); PG8_STAGE(PG8_SA(0, 0), a2, voffA);
            PG8_WAIT_V(8); PG8_WAIT_L(0); PG8_BAR; PG8_MMA(1, 0, At, B0); PG8_MMA(1, 1, At, B1); PG8_BAR; PG8_SCHED;
            PG8_LDB(B0, 1, 0); PG8_LDB(B1, 1, 1); PG8_SCHED; PG8_LDA(At, 1, 0); PG8_STAGE(PG8_SA(0, 1), a2 + hstep, voffA);
            PG8_WAIT_V(8); PG8_WAIT_L(0); PG8_BAR; PG8_MMA(0, 0, At, B0); PG8_MMA(0, 1, At, B1); PG8_BAR; PG8_SCHED;
            PG8_LDA(At, 1, 1); PG8_STAGE(PG8_SB(1, 0), b3, voffB); PG8_STAGE(PG8_SB(1, 1), b3 + hstep, voffB); PG8_STAGE(PG8_SA(1, 0), a3, voffA);
            PG8_WAIT_V(8); PG8_WAIT_L(0); PG8_BAR; PG8_MMA(1, 0, At, B0); PG8_MMA(1, 1, At, B1); PG8_BAR; PG8_SCHED;
            } else {
            PG8_LDB(B0, 0, 0); PG8_SCHED; PG8_LDA(At, 0, 0); PG8_STAGE(PG8_SA(1, 1), a1 + hstep, voffA);
            PG8_WAIT_L(8); PG8_BAR; PG8_WAIT_L(0); PG8_MMA(0, 0, At, B0); PG8_BAR; PG8_SCHED;
            PG8_LDB(B1, 0, 1); PG8_STAGE(PG8_SB(0, 0), b2, voffB);
            PG8_BAR; PG8_WAIT_L(0); PG8_MMA(0, 1, At, B1); PG8_BAR;
            PG8_LDA(At, 0, 1); PG8_STAGE(PG8_SA(0, 0), a2, voffA);
            PG8_BAR; PG8_WAIT_L(0); PG8_MMA(1, 0, At, B0); PG8_BAR; PG8_SCHED;
            PG8_STAGE(PG8_SB(0, 1), b2 + hstep, voffB);
            PG8_WAIT_V(6); PG8_BAR; PG8_MMA(1, 1, At, B1); PG8_BAR;
            PG8_LDB(B0, 1, 0); PG8_SCHED; PG8_LDA(At, 1, 0); PG8_STAGE(PG8_SA(0, 1), a2 + hstep, voffA);
            PG8_WAIT_L(8); PG8_BAR; PG8_WAIT_L(0); PG8_MMA(0, 0, At, B0); PG8_BAR; PG8_SCHED;
            PG8_LDB(B1, 1, 1); PG8_STAGE(PG8_SB(1, 0), b3, voffB);
            PG8_BAR; PG8_WAIT_L(0); PG8_MMA(0, 1, At, B1); PG8_BAR;
            PG8_LDA(At, 1, 1); PG8_STAGE(PG8_SA(1, 0), a3, voffA);
            PG8_BAR; PG8_WAIT_L(0); PG8_MMA(1, 0, At, B0); PG8_BAR; PG8_SCHED;
            PG8_STAGE(PG8_SB(1, 1), b3 + hstep, voffB);
            PG8_WAIT_V(6); PG8_BAR; PG8_MMA(1, 1, At, B1); PG8_BAR;
            }
        }
        if constexpr (ALIGN_EPI) { if (wr == 0) PG8_BAR; }
        if constexpr (!Epi::AFTER_DRAIN) { E(acc, cur, wr, wc, fr, fq, ui); S.done(cur); }
        if (!has_next) break;
#pragma unroll
        for (int a = 0; a < 2; ++a)
#pragma unroll
            for (int b = 0; b < 2; ++b)
#pragma unroll
                for (int m = 0; m < 4; ++m)
#pragma unroll
                    for (int n = 0; n < 2; ++n) acc[a][b][m][n] = (f32x4){0.f, 0.f, 0.f, 0.f};
        cur = nxt; cA = nA; cB = nB; ++ui;
        if constexpr (ALIGN_EPI) { if (wr == 1) PG8_BAR; }
    }
    PG8_WAIT_V(0);
    if constexpr (!ALIGN_EPI) { if (wr == 0) PG8_BAR; }
    PG8_BAR;
    if constexpr (Epi::AFTER_DRAIN) { E.fused(acc, cur, wr, wc, fr, fq, lds, wid, lane); S.done(cur); }
#undef PG8_SA
#undef PG8_SB
#undef PG8_STAGE
#undef PG8_LDA
#undef PG8_LDB
#undef PG8_MMA
#undef PG8_WAIT_V
#undef PG8_WAIT_L
#undef PG8_BAR
#undef PG8_SCHED
}
}
constexpr int NWAVES = 8, NT = NWAVES * 64;
constexpr int M = 16384, D = 1024, FF = 2816, SEQ = 4096, NCH = 64  , NITEM = 16 * NCH  ;
constexpr int INC = 8208;
constexpr float EPS = 1e-6f;
constexpr size_t MiB = 1u << 20;
constexpr size_t WS_CTL = 0, CTL_ZERO_BYTES = 64 * 1024;
constexpr size_t WS_SS1 = 254 * MiB, WS_SS2 = 42 * MiB, WS_SS3 = 43 * MiB, WS_SS4 = 236 * MiB;
constexpr size_t WS_HB3 = 204 * MiB;
constexpr size_t WS_GLR = 1 * MiB;
constexpr size_t WS_DEC = 2 * MiB;
constexpr size_t WS_WGLR = 2 * MiB + 768 * 1024;
constexpr size_t WS_WGU = 3 * MiB;
constexpr size_t WS_WD = 14 * MiB;
constexpr size_t WS_WIN = 20 * MiB;
constexpr size_t WS_WOC = 36 * MiB, WS_WOG = 38 * MiB, WS_WO = 40 * MiB;
constexpr size_t WS_H = 44 * MiB;
constexpr size_t WS_ACT = 76 * MiB;
constexpr size_t WS_Q = 76 * MiB, WS_K = 92 * MiB, WS_V = 108 * MiB, WS_R = 140 * MiB  , WS_KV = 172 * MiB;
constexpr size_t WS_CB = 76 * MiB  , WS_P = 108 * MiB  , WS_GA = 172 * MiB, WS_GB = 204 * MiB;
constexpr size_t WS_WGU2 = 237 * MiB, WS_WD2 = 248 * MiB;
constexpr size_t WS_END = 255 * MiB;
constexpr int LDS_BYTES = 147456;

#define LAS __attribute__((address_space(3)))
typedef unsigned short bf16;
typedef float f32x4 __attribute__((ext_vector_type(4)));
typedef short bf16x8 __attribute__((ext_vector_type(8)));
typedef unsigned u32x4 __attribute__((ext_vector_type(4)));
typedef unsigned u32x2 __attribute__((ext_vector_type(2)));
using pg8::cvt_pk_bf16; using pg8::bflo; using pg8::bfhi;
#define LDS_WAIT() asm volatile("s_waitcnt lgkmcnt(0)" ::: "memory")
#define MFMA16(a, b, c) __builtin_amdgcn_mfma_f32_16x16x32_bf16((a), (b), (c), 0, 0, 0)

__device__ __forceinline__ float wave_sum(float v) {
#pragma unroll
    for (int o = 1; o < 64; o <<= 1) v += __shfl_xor(v, o);
    return v;
}
__device__ __forceinline__ float bf2f(bf16 b) { return __uint_as_float(((unsigned)b) << 16); }

__device__ __forceinline__ void tr_item(const float* W, int N, int K, int k0, int src_n0, bf16* WT, int dst_row0, LAS bf16* T, int lane, const float* gk) {
    const int n4 = lane & 15, kr = lane >> 4;
    const float* src = W + (size_t)(k0 + 2 * kr) * N + src_n0 + 4 * n4;
    f32x4 a[8], b[8];
#pragma unroll
    for (int i = 0; i < 8; ++i) { a[i] = *(const f32x4*)(src + (size_t)(8 * i) * N); b[i] = *(const f32x4*)(src + (size_t)(8 * i + 1) * N); }
#pragma unroll
    for (int i = 0; i < 8; ++i) { float g0 = 1.f, g1 = 1.f; if (gk) { g0 = gk[k0 + 8 * i + 2 * kr]; g1 = gk[k0 + 8 * i + 2 * kr + 1]; }
#pragma unroll
        for (int c = 0; c < 4; ++c) *(LAS unsigned*)(T + (4 * n4 + c) * 64 + ((i ^ (n4 & 7)) << 3) + 2 * kr) = cvt_pk_bf16(a[i][c] * g0, b[i][c] * g1); }
    LDS_WAIT(); asm volatile("" ::: "memory");
    const int c8 = lane & 7;
#pragma unroll
    for (int j = 0; j < 8; ++j) { const int n = (lane >> 3) + 8 * j; const u32x4 o = *(const LAS u32x4*)(T + n * 64 + ((c8 ^ ((n >> 2) & 7)) << 3));
        *(u32x4*)(WT + (size_t)(dst_row0 + n) * K + k0 + 8 * c8) = o; }
    LDS_WAIT(); asm volatile("" ::: "memory");
}
__device__ __forceinline__ int src_gu(int d0) { const int tile = d0 >> 8, half = (d0 >> 7) & 1, off = d0 & 127; return half * FF + 128 * tile + off; }
__device__ __forceinline__ int src_win(int d0) {
    if (d0 < 512) return 3072 + d0;
    if (d0 < 1024) return 3584 + (d0 - 512);
    if (d0 < 2048) return 4096 + (d0 - 1024);
    if (d0 < 3072) return 5136 + (d0 - 2048);
    if (d0 < 4096) return d0 - 3072;
    if (d0 < 6144) { const int j = d0 - 4096, tile = j >> 8, half = (j >> 7) & 1, off = j & 127; return (half ? 2048 : 1024) + 128 * tile + off; }
    if (d0 < 7168) return 6160 + (d0 - 6144);
    return 7184 + (d0 - 7168);
}
template <int KIND> __device__ __forceinline__ void tr_matrix(const float* W, int N, int K, int Ndst, bf16* WT, LAS bf16* scr, int gw, int ngw, int lane, const float* gk) {
    const int nblk = Ndst / 64, items = (K / 64) * nblk;
    for (int it = gw; it < items; it += ngw) { const int kb = it / nblk, nb = it % nblk, d0 = nb * 64;
        const int s0 = KIND == 0 ? d0 : (KIND == 1 ? src_gu(d0) : src_win(d0));
        tr_item(W, N, K, kb * 64, s0, WT, d0, scr, lane, gk); }
}
__device__ __forceinline__ void norm_row_bf16(const float* xrow, const float* g, bf16* orow, int lane) {
    const f32x4* xr = (const f32x4*)xrow + lane; f32x4 v[4]; float s = 0.f;
#pragma unroll
    for (int j = 0; j < 4; ++j) { v[j] = xr[64 * j]; s += (v[j].x * v[j].x + v[j].y * v[j].y) + (v[j].z * v[j].z + v[j].w * v[j].w); }
    const float rinv = rsqrtf(wave_sum(s) * (1.f / D) + EPS);
    u32x2* o8 = (u32x2*)orow + lane;
#pragma unroll
    for (int j = 0; j < 4; ++j) { const f32x4 gg = ((const f32x4*)g)[lane + 64 * j]; const f32x4 o = v[j] * rinv * gg; u32x2 w; w.x = cvt_pk_bf16(o.x, o.y); w.y = cvt_pk_bf16(o.z, o.w); o8[64 * j] = w; }
}
__device__ __forceinline__ void cvt_row_bf16(const float* xrow, bf16* orow, float* ssp, int lane) {
    const f32x4* xr = (const f32x4*)xrow + lane; f32x4 v[4]; float s = 0.f;
#pragma unroll
    for (int j = 0; j < 4; ++j) { v[j] = xr[64 * j]; s += (v[j].x * v[j].x + v[j].y * v[j].y) + (v[j].z * v[j].z + v[j].w * v[j].w); }
    s = wave_sum(s); if (lane < 16) ssp[lane] = lane == 0 ? s : 0.f;
    u32x2* o8 = (u32x2*)orow + lane;
#pragma unroll
    for (int j = 0; j < 4; ++j) { u32x2 w; w.x = cvt_pk_bf16(v[j].x, v[j].y); w.y = cvt_pk_bf16(v[j].z, v[j].w); o8[64 * j] = w; }
}
__device__ __forceinline__ void glr_16(const bf16* HB, const bf16* WglrT, const float* ss, float* GLR, int r0, int lane) {
    const int fr = lane & 15, fq = lane >> 4;
    const bf16* hr = HB + (size_t)(r0 + fr) * D + fq * 8; const bf16* wrp = WglrT + fr * D + fq * 8;
    f32x4 acc = {0.f, 0.f, 0.f, 0.f};
#pragma unroll 8
    for (int s = 0; s < 32; ++s) { const bf16x8 af = *(const bf16x8*)(hr + 32 * s), bfv = *(const bf16x8*)(wrp + 32 * s); acc = MFMA16(af, bfv, acc); }
#pragma unroll
    for (int j = 0; j < 4; ++j) { const int row = r0 + fq * 4 + j; GLR[(size_t)row * 16 + fr] = acc[j] * pg8::row_rinv(ss, row); }
}
__device__ __forceinline__ void norm_row_f32(const float* xrow, const float* g, float* orow, int lane) {
    const f32x4* xr = (const f32x4*)xrow + lane; f32x4 v[4]; float s = 0.f;
#pragma unroll
    for (int j = 0; j < 4; ++j) { v[j] = xr[64 * j]; s += (v[j].x * v[j].x + v[j].y * v[j].y) + (v[j].z * v[j].z + v[j].w * v[j].w); }
    const float rinv = rsqrtf(wave_sum(s) * (1.f / D) + EPS);
#pragma unroll
    for (int j = 0; j < 4; ++j) { const f32x4 gg = ((const f32x4*)g)[lane + 64 * j]; ((f32x4*)orow)[lane + 64 * j] = v[j] * rinv * gg; }
}
__device__ __forceinline__ void norm_mix_16(const float* X, const float* g, const bf16* WglrT, bf16* H, float* GLR, int r0, int lane) {
    const int fr = lane & 15, fq = lane >> 4;
    const float* xr = X + (size_t)(r0 + fr) * D + fq * 8;
    float ss = 0.f;
#pragma unroll 8
    for (int s = 0; s < 32; ++s) { const f32x4 a = *(const f32x4*)(xr + 32 * s), b = *(const f32x4*)(xr + 32 * s + 4);
        ss += (a.x * a.x + a.y * a.y) + (a.z * a.z + a.w * a.w) + (b.x * b.x + b.y * b.y) + (b.z * b.z + b.w * b.w); }
    ss += __shfl_xor(ss, 16); ss += __shfl_xor(ss, 32);
    const float rinv = rsqrtf(ss * (1.f / D) + EPS);
    f32x4 acc = {0.f, 0.f, 0.f, 0.f};
    bf16* hr = H + (size_t)(r0 + fr) * D + fq * 8; const bf16* wrp = WglrT + fr * D + fq * 8; const float* gp = g + fq * 8;
#pragma unroll 4
    for (int s = 0; s < 32; ++s) { const f32x4 a = *(const f32x4*)(xr + 32 * s), b = *(const f32x4*)(xr + 32 * s + 4);
        const f32x4 ga = *(const f32x4*)(gp + 32 * s), gb = *(const f32x4*)(gp + 32 * s + 4);
        const f32x4 ha = a * rinv * ga, hb = b * rinv * gb;
        u32x4 hv; hv.x = cvt_pk_bf16(ha.x, ha.y); hv.y = cvt_pk_bf16(ha.z, ha.w); hv.z = cvt_pk_bf16(hb.x, hb.y); hv.w = cvt_pk_bf16(hb.z, hb.w);
        *(u32x4*)(hr + 32 * s) = hv;
        const bf16x8 af = __builtin_bit_cast(bf16x8, hv); const bf16x8 bfv = *(const bf16x8*)(wrp + 32 * s);
        acc = MFMA16(af, bfv, acc); }
#pragma unroll
    for (int j = 0; j < 4; ++j) GLR[(size_t)(r0 + fq * 4 + j) * 16 + fr] = acc[j];
}

__device__ __forceinline__ float logsig16(float x) { const float e = __expf(-fabsf(x)); return (fminf(x, 0.f) - __logf(1.0f + e)) * (1.0f / 16.0f); }

struct GlaPtrs { const float* GLR; const float* Wup; const float* gate_b; const float* gnorm; const bf16* Q; const bf16* K; const bf16* V; bf16* RY; bf16* KV; float* DEC; };

#define GLA_GATE_PREFIX() \
    const int d = tid & 127, tg = tid >> 7; \
    float wup[16]; \
    _Pragma("unroll") for (int j = 0; j < 16; ++j) wup[j] = P.Wup[j * 512 + h * 128 + d]; \
    const float gbias = P.gate_b[h * 128 + d]; \
    if (tid < 256) ((LAS f32x4*)glr_s)[tid] = ((const f32x4*)(P.GLR + (size_t)row0 * 16))[tid];

__device__ __forceinline__ void gla_a_item(LAS unsigned char* lds, const GlaPtrs& P, int item, int tid) {
    const int bh = item >> 6, n = item & 63, b = bh >> 2, h = bh & 3, row0 = b * SEQ + n * 64;
    LAS float* glr_s = (LAS float*)lds;
    LAS float* gsum = (LAS float*)(lds + 4096);
    LAS bf16* kT = (LAS bf16*)(lds + 8192);
    LAS bf16* vT = (LAS bf16*)(lds + 26624);
    GLA_GATE_PREFIX()
    float kk[16];
#pragma unroll
    for (int i = 0; i < 16; ++i) kk[i] = bf2f(P.K[(size_t)(row0 + tg * 16 + i) * 512 + h * 128 + d]);
    unsigned vw[16];
    { const int vp = tid & 127, tq = tid >> 7;
#pragma unroll
      for (int i = 0; i < 16; ++i) vw[i] = *(const unsigned*)(P.V + (size_t)(row0 + tq * 16 + i) * 1024 + h * 256 + 2 * vp); }
    __syncthreads();
    float bl[16]; float run = 0.f;
#pragma unroll
    for (int i = 0; i < 16; ++i) { float pre = gbias; const LAS f32x4* gr = (const LAS f32x4*)(glr_s + (tg * 16 + i) * 16);
#pragma unroll
        for (int j4 = 0; j4 < 4; ++j4) { const f32x4 gv = gr[j4]; pre += gv.x * wup[4 * j4] + gv.y * wup[4 * j4 + 1] + gv.z * wup[4 * j4 + 2] + gv.w * wup[4 * j4 + 3]; }
        run += logsig16(pre); bl[i] = run; }
    gsum[tg * 128 + d] = run;
    __syncthreads();
    const float g0 = gsum[d], g1 = gsum[128 + d], g2 = gsum[256 + d], g3 = gsum[384 + d];
    const float off = (tg > 0 ? g0 : 0.f) + (tg > 1 ? g1 : 0.f) + (tg > 2 ? g2 : 0.f);
    const float blast = (g0 + g1) + (g2 + g3);
    { float ks[16];
#pragma unroll
      for (int i = 0; i < 16; ++i) ks[i] = kk[i] * __expf(blast - (bl[i] + off));
      u32x4 w0, w1; w0.x = cvt_pk_bf16(ks[0], ks[1]); w0.y = cvt_pk_bf16(ks[2], ks[3]); w0.z = cvt_pk_bf16(ks[4], ks[5]); w0.w = cvt_pk_bf16(ks[6], ks[7]);
      w1.x = cvt_pk_bf16(ks[8], ks[9]); w1.y = cvt_pk_bf16(ks[10], ks[11]); w1.z = cvt_pk_bf16(ks[12], ks[13]); w1.w = cvt_pk_bf16(ks[14], ks[15]);
      *(LAS u32x4*)(kT + d * 72 + tg * 16) = w0; *(LAS u32x4*)(kT + d * 72 + tg * 16 + 8) = w1; }
    if (tg == 0) P.DEC[(size_t)item * 128 + d] = __expf(blast);
    { const int vp = tid & 127, tq = tid >> 7;
      u32x4 l0, l1, h0, h1;
#define PKLO(a, b) (((a) & 0xffffu) | ((b) << 16))
#define PKHI(a, b) (((a) >> 16) | ((b) & 0xffff0000u))
      l0.x = PKLO(vw[0], vw[1]); l0.y = PKLO(vw[2], vw[3]); l0.z = PKLO(vw[4], vw[5]); l0.w = PKLO(vw[6], vw[7]);
      l1.x = PKLO(vw[8], vw[9]); l1.y = PKLO(vw[10], vw[11]); l1.z = PKLO(vw[12], vw[13]); l1.w = PKLO(vw[14], vw[15]);
      h0.x = PKHI(vw[0], vw[1]); h0.y = PKHI(vw[2], vw[3]); h0.z = PKHI(vw[4], vw[5]); h0.w = PKHI(vw[6], vw[7]);
      h1.x = PKHI(vw[8], vw[9]); h1.y = PKHI(vw[10], vw[11]); h1.z = PKHI(vw[12], vw[13]); h1.w = PKHI(vw[14], vw[15]);
      *(LAS u32x4*)(vT + (2 * vp) * 72 + tq * 16) = l0; *(LAS u32x4*)(vT + (2 * vp) * 72 + tq * 16 + 8) = l1;
      *(LAS u32x4*)(vT + (2 * vp + 1) * 72 + tq * 16) = h0; *(LAS u32x4*)(vT + (2 * vp + 1) * 72 + tq * 16 + 8) = h1; }
    __syncthreads();
    { const int w = tid >> 6, lane = tid & 63, fr = lane & 15, fq = lane >> 4;
      bf16x8 vf[2][2];
#pragma unroll
      for (int vt = 0; vt < 2; ++vt)
#pragma unroll
          for (int ks = 0; ks < 2; ++ks) vf[vt][ks] = *(const LAS bf16x8*)(vT + ((2 * w + vt) * 16 + fr) * 72 + ks * 32 + fq * 8);
      bf16* kvb = P.KV + (size_t)item * (256 * 128);
#pragma unroll
      for (int dt = 0; dt < 8; ++dt) {
          const bf16x8 k0 = *(const LAS bf16x8*)(kT + (dt * 16 + fr) * 72 + fq * 8), k1 = *(const LAS bf16x8*)(kT + (dt * 16 + fr) * 72 + 32 + fq * 8);
#pragma unroll
          for (int vt = 0; vt < 2; ++vt) { f32x4 acc = {0.f, 0.f, 0.f, 0.f};
              acc = MFMA16(k0, vf[vt][0], acc); acc = MFMA16(k1, vf[vt][1], acc);
              u32x2 o; o.x = cvt_pk_bf16(acc[0], acc[1]); o.y = cvt_pk_bf16(acc[2], acc[3]);
              *(u32x2*)(kvb + (size_t)((2 * w + vt) * 16 + fr) * 128 + dt * 16 + fq * 4) = o; } } }
    __syncthreads();
}

__device__ __forceinline__ void gla_c_item(LAS unsigned char* lds, const GlaPtrs& P, int item, int tid) {
    const int bh = item >> 6, n = item & 63, b = bh >> 2, h = bh & 3, row0 = b * SEQ + n * 64;
    LAS float* glr_s = (LAS float*)lds;
    LAS float* gsum = (LAS float*)(lds + 4096);
    LAS float* ss_s = (LAS float*)(lds + 6144);
    LAS bf16* qi = (LAS bf16*)(lds + 8192);
    LAS bf16* qr = (LAS bf16*)(lds + 25600);
    LAS bf16* kr = (LAS bf16*)(lds + 43008);
    LAS bf16* vT = (LAS bf16*)(lds + 60416);
    LAS bf16* sc = (LAS bf16*)(lds + 97280);
    GLA_GATE_PREFIX()
    float qq[16], kk[16];
#pragma unroll
    for (int i = 0; i < 16; ++i) { const size_t o = (size_t)(row0 + tg * 16 + i) * 512 + h * 128 + d; qq[i] = bf2f(P.Q[o]); kk[i] = bf2f(P.K[o]); }
    unsigned vw[16];
    { const int vp = tid & 127, tq = tid >> 7;
#pragma unroll
      for (int i = 0; i < 16; ++i) vw[i] = *(const unsigned*)(P.V + (size_t)(row0 + tq * 16 + i) * 1024 + h * 256 + 2 * vp); }
    __syncthreads();
    float bl[16]; float run = 0.f;
#pragma unroll
    for (int i = 0; i < 16; ++i) { float pre = gbias; const LAS f32x4* gr = (const LAS f32x4*)(glr_s + (tg * 16 + i) * 16);
#pragma unroll
        for (int j4 = 0; j4 < 4; ++j4) { const f32x4 gv = gr[j4]; pre += gv.x * wup[4 * j4] + gv.y * wup[4 * j4 + 1] + gv.z * wup[4 * j4 + 2] + gv.w * wup[4 * j4 + 3]; }
        run += logsig16(pre); bl[i] = run; }
    gsum[tg * 128 + d] = run;
    __syncthreads();
    { const float g0 = gsum[d], g1 = gsum[128 + d], g2 = gsum[256 + d];
      const float off = (tg > 0 ? g0 : 0.f) + (tg > 1 ? g1 : 0.f) + (tg > 2 ? g2 : 0.f);
      const float bref = g0 + g1;
#pragma unroll
      for (int i = 0; i < 16; ++i) { const float bb = bl[i] + off; const int t = tg * 16 + i;
          const float e1 = __expf(bb), e2 = __expf(bb - bref), e3 = __expf(bref - bb);
          qi[t * 136 + d] = (bf16)(cvt_pk_bf16(qq[i] * e1, 0.f) & 0xffffu);
          qr[t * 136 + d] = (bf16)(cvt_pk_bf16(qq[i] * e2, 0.f) & 0xffffu);
          kr[t * 136 + d] = (bf16)(cvt_pk_bf16(kk[i] * e3, 0.f) & 0xffffu); } }
    { const int vp = tid & 127, tq = tid >> 7;
      u32x4 l0, l1, h0, h1;
      l0.x = PKLO(vw[0], vw[1]); l0.y = PKLO(vw[2], vw[3]); l0.z = PKLO(vw[4], vw[5]); l0.w = PKLO(vw[6], vw[7]);
      l1.x = PKLO(vw[8], vw[9]); l1.y = PKLO(vw[10], vw[11]); l1.z = PKLO(vw[12], vw[13]); l1.w = PKLO(vw[14], vw[15]);
      h0.x = PKHI(vw[0], vw[1]); h0.y = PKHI(vw[2], vw[3]); h0.z = PKHI(vw[4], vw[5]); h0.w = PKHI(vw[6], vw[7]);
      h1.x = PKHI(vw[8], vw[9]); h1.y = PKHI(vw[10], vw[11]); h1.z = PKHI(vw[12], vw[13]); h1.w = PKHI(vw[14], vw[15]);
      *(LAS u32x4*)(vT + (2 * vp) * 72 + tq * 16) = l0; *(LAS u32x4*)(vT + (2 * vp) * 72 + tq * 16 + 8) = l1;
      *(LAS u32x4*)(vT + (2 * vp + 1) * 72 + tq * 16) = h0; *(LAS u32x4*)(vT + (2 * vp + 1) * 72 + tq * 16 + 8) = h1; }
    __syncthreads();
    const int w = tid >> 6, lane = tid & 63, fr = lane & 15, fq = lane >> 4;
    { const int it = w >> 1;
#pragma unroll
      for (int jj = 0; jj < 2; ++jj) { const int jt = 2 * (w & 1) + jj; f32x4 acc = {0.f, 0.f, 0.f, 0.f};
#pragma unroll
          for (int ks = 0; ks < 4; ++ks) { const bf16x8 x = *(const LAS bf16x8*)(kr + (jt * 16 + fr) * 136 + ks * 32 + fq * 8), y = *(const LAS bf16x8*)(qr + (it * 16 + fr) * 136 + ks * 32 + fq * 8);
              acc = MFMA16(x, y, acc); }
          const int i = it * 16 + fr, j0 = jt * 16 + fq * 4;
          u32x2 o; o.x = cvt_pk_bf16(j0 <= i ? acc[0] : 0.f, j0 + 1 <= i ? acc[1] : 0.f); o.y = cvt_pk_bf16(j0 + 2 <= i ? acc[2] : 0.f, j0 + 3 <= i ? acc[3] : 0.f);
          *(LAS u32x2*)(sc + i * 72 + j0) = o; } }
    __syncthreads();
    f32x4 acc[4][2];
    { const bf16* Sb = P.KV + (size_t)item * (256 * 128);
#pragma unroll
      for (int vt = 0; vt < 2; ++vt) { const int v0 = (2 * w + vt) * 16;
          bf16x8 xv[2], xs[4];
#pragma unroll
          for (int ks = 0; ks < 2; ++ks) xv[ks] = *(const LAS bf16x8*)(vT + (v0 + fr) * 72 + ks * 32 + fq * 8);
#pragma unroll
          for (int ks = 0; ks < 4; ++ks) xs[ks] = *(const bf16x8*)(Sb + (size_t)(v0 + fr) * 128 + ks * 32 + fq * 8);
#pragma unroll
          for (int it = 0; it < 4; ++it) { f32x4 a = {0.f, 0.f, 0.f, 0.f};
#pragma unroll
              for (int ks = 0; ks < 2; ++ks) { const bf16x8 y = *(const LAS bf16x8*)(sc + (it * 16 + fr) * 72 + ks * 32 + fq * 8); a = MFMA16(xv[ks], y, a); }
#pragma unroll
              for (int ks = 0; ks < 4; ++ks) { const bf16x8 y = *(const LAS bf16x8*)(qi + (it * 16 + fr) * 136 + ks * 32 + fq * 8); a = MFMA16(xs[ks], y, a); }
              acc[it][vt] = a; } } }
#pragma unroll
    for (int it = 0; it < 4; ++it) { float p = 0.f;
#pragma unroll
        for (int vt = 0; vt < 2; ++vt) p += (acc[it][vt][0] * acc[it][vt][0] + acc[it][vt][1] * acc[it][vt][1]) + (acc[it][vt][2] * acc[it][vt][2] + acc[it][vt][3] * acc[it][vt][3]);
        p += __shfl_xor(p, 16); p += __shfl_xor(p, 32);
        if (fq == 0) ss_s[w * 64 + it * 16 + fr] = p; }
    __syncthreads();
#pragma unroll
    for (int it = 0; it < 4; ++it) { float tot = 0.f;
#pragma unroll
        for (int ww = 0; ww < 8; ++ww) tot += ss_s[ww * 64 + it * 16 + fr];
        const float rinv = rsqrtf(tot * (1.f / 256.f) + EPS);
#pragma unroll
        for (int vt = 0; vt < 2; ++vt) { const int col = h * 256 + (2 * w + vt) * 16 + fq * 4; bf16* p = P.RY + (size_t)(row0 + it * 16 + fr) * 1024 + col;
            const u32x2 rw = *(const u32x2*)p; const f32x4 gn = *(const f32x4*)(P.gnorm + col); const f32x4 a = acc[it][vt];
            u32x2 o; o.x = cvt_pk_bf16(a[0] * rinv * gn[0] * bflo(rw.x), a[1] * rinv * gn[1] * bfhi(rw.x)); o.y = cvt_pk_bf16(a[2] * rinv * gn[2] * bflo(rw.y), a[3] * rinv * gn[3] * bfhi(rw.y));
            *(u32x2*)p = o; } }
    __syncthreads();
}

__device__ __forceinline__ void gla_scan(bf16* KV, const float* DEC, int gtid, int gthreads) {
    for (int e = gtid; e < 16 * 256 * 32; e += gthreads) { const int bh = e >> 13, rem = e & 8191, v = rem >> 5, d4 = rem & 31;
        bf16* base = KV + ((size_t)(bh * 64) * 256 + v) * 128 + d4 * 4; const float* dc = DEC + (size_t)(bh * 64) * 128 + d4 * 4;
        f32x4 S = {0.f, 0.f, 0.f, 0.f};
        for (int nb = 0; nb < 8; ++nb) { u32x2 kv[8]; f32x4 dv[8];
#pragma unroll
            for (int u = 0; u < 8; ++u) { kv[u] = *(const u32x2*)(base + (size_t)(nb * 8 + u) * 32768); dv[u] = *(const f32x4*)(dc + (nb * 8 + u) * 128); }
#pragma unroll
            for (int u = 0; u < 8; ++u) { u32x2 o; o.x = cvt_pk_bf16(S[0], S[1]); o.y = cvt_pk_bf16(S[2], S[3]); *(u32x2*)(base + (size_t)(nb * 8 + u) * 32768) = o;
                const f32x4 k4 = {bflo(kv[u].x), bfhi(kv[u].x), bflo(kv[u].y), bfhi(kv[u].y)}; S = dv[u] * S + k4; } } }
}
__device__ __forceinline__ void conv_pass(bf16* CB, const bf16* Pp, const float* cw, int gtid, int gthreads) {
    for (int e = gtid; e < M * 128; e += gthreads) { const int row = e >> 7, c = (e & 127) * 8, s = row & (SEQ - 1);
        const u32x4 z = {0u, 0u, 0u, 0u};
        const u32x4 cbw = *(const u32x4*)(CB + (size_t)row * 1024 + c), p0 = *(const u32x4*)(Pp + (size_t)row * 1024 + c);
        const u32x4 p1 = s >= 1 ? *(const u32x4*)(Pp + (size_t)(row - 1) * 1024 + c) : z, p2 = s >= 2 ? *(const u32x4*)(Pp + (size_t)(row - 2) * 1024 + c) : z;
        f32x4 a0, a1, b0, b1, c0, c1, d0, d1; pg8::unpack8(cbw, a0, a1); pg8::unpack8(p0, b0, b1); pg8::unpack8(p1, c0, c1); pg8::unpack8(p2, d0, d1);
        const f32x4 w00 = *(const f32x4*)(cw + c), w01 = *(const f32x4*)(cw + c + 4), w10 = *(const f32x4*)(cw + 1024 + c), w11 = *(const f32x4*)(cw + 1024 + c + 4), w20 = *(const f32x4*)(cw + 2048 + c), w21 = *(const f32x4*)(cw + 2048 + c + 4);
        const f32x4 y0 = a0 * (w00 * d0 + w10 * c0 + w20 * b0), y1 = a1 * (w01 * d1 + w11 * c1 + w21 * b1);
        *(u32x4*)(CB + (size_t)row * 1024 + c) = pg8::pack8(y0, y1); }
}

#define XB_TMO      128
#define XB_XCNT(j)  (256  + 64 * (j))
#define XB_XSUB(j)  (1280 + 64 * (j))
#define XB_XGEN(j)  (2304 + 64 * (j))
#define XB_TOP      3328
#define XB_TOPGEN   3392
#define XCD_BAR_WORDS 3456
#define XB_SPIN_CAP (1u << 18)

__device__ __forceinline__ unsigned xb_ld(unsigned* p)              { return __hip_atomic_load(p, __ATOMIC_RELAXED, __HIP_MEMORY_SCOPE_AGENT); }
__device__ __forceinline__ unsigned xb_add(unsigned* p, unsigned v) { return __hip_atomic_fetch_add(p, v, __ATOMIC_RELAXED, __HIP_MEMORY_SCOPE_AGENT); }
__device__ __forceinline__ unsigned xb_xcc_id() { return (unsigned)__builtin_amdgcn_s_getreg((3 << 11) | 20) & 0xFu; }
#define XB_SPIN(cond, bar) do { unsigned _sp = 0; while (cond) { __builtin_amdgcn_s_sleep(1); \
    if ((++_sp & 255u) == 0u) { if (xb_ld(&(bar)[XB_TMO])) break; if (_sp > XB_SPIN_CAP) { atomicAdd(&(bar)[XB_TMO], 1u); break; } } } } while (0)

struct XcdBarrier {
    unsigned* bar; unsigned x;
    volatile LAS unsigned* st;
};

__device__ __forceinline__ XcdBarrier xcd_barrier_post(unsigned* bar, volatile LAS unsigned* st) {
    XcdBarrier b; b.bar = bar; b.x = xb_xcc_id(); b.st = st;
    if (threadIdx.x == 0) (void)xb_add(&bar[XB_XCNT(b.x)], 1u);
    return b;
}
__device__ __forceinline__ void xcd_barrier_complete(unsigned* bar, unsigned x, unsigned& nloc, unsigned& nx) {
    const unsigned G = gridDim.x * gridDim.y * gridDim.z;
    unsigned sum, cnt, mine, sp = 0u;
    for (;;) {
        sum = 0u; cnt = 0u; mine = 0u;
#pragma unroll
        for (unsigned j = 0; j < 16; ++j) { const unsigned c = xb_ld(&bar[XB_XCNT(j)]); sum += c; cnt += (c > 0u) ? 1u : 0u; mine = (j == x) ? c : mine; }
        if (sum == G) break;
        __builtin_amdgcn_s_sleep(1);
        if ((++sp & 255u) == 0u) { if (xb_ld(&bar[XB_TMO])) break; if (sp > XB_SPIN_CAP) { atomicAdd(&bar[XB_TMO], 1u); break; } }
    }
    nloc = mine > 0u ? mine : 1u; nx = cnt > 0u ? cnt : 1u;
}

__device__ __forceinline__ void xcd_barrier(const XcdBarrier& b) {
    asm volatile("s_waitcnt vmcnt(0)" ::: "memory");
    __syncthreads();
    if (threadIdx.x == 0) {
        unsigned* bar = b.bar;
        __builtin_amdgcn_s_waitcnt(0);
        unsigned nloc = b.st[0], nx = b.st[1];
        if (nloc == 0u) { xcd_barrier_complete(bar, b.x, nloc, nx); b.st[0] = nloc; b.st[1] = nx; }
        const unsigned old = xb_add(&bar[XB_XSUB(b.x)], 1u);
        const unsigned gen = old / nloc;
        if (old + 1u == (gen + 1u) * nloc) {
            __builtin_amdgcn_fence(__ATOMIC_RELEASE, "agent");
            asm volatile("s_waitcnt vmcnt(0)" ::: "memory");
            const unsigned og = xb_add(&bar[XB_TOP], 1u);
            const unsigned tg = og / nx;
            if (og + 1u == (tg + 1u) * nx) xb_add(&bar[XB_TOPGEN], 1u);
            else XB_SPIN(xb_ld(&bar[XB_TOPGEN]) == tg, bar);
            __builtin_amdgcn_fence(__ATOMIC_ACQUIRE, "agent");
            xb_add(&bar[XB_XGEN(b.x)], 1u);
            asm volatile("s_waitcnt vmcnt(0)" ::: "memory");
        } else {
            XB_SPIN(xb_ld(&bar[XB_XGEN(b.x)]) == gen, bar);
            __builtin_amdgcn_fence(__ATOMIC_ACQUIRE, "agent");
            asm volatile("s_waitcnt vmcnt(0)" ::: "memory");
        }
    }
    __syncthreads();
}

struct Args { const float* in[17]; float* out; unsigned char* ws; int ph_lo, ph_hi; };
constexpr int NPHASE = 14;
#ifndef MK_SPLIT
#define MK_SPLIT 0
#endif

__global__ void __launch_bounds__(NT, 2) mega_fwd(Args args) {
    extern __shared__ __attribute__((aligned(16))) unsigned char lds_raw[];
    LAS unsigned char* lds = (LAS unsigned char*)lds_raw;
#define FRESH_TID() int tid = threadIdx.x; asm volatile("" : "+v"(tid)); const int lane = tid & 63; const int wave = __builtin_amdgcn_readfirstlane(tid >> 6); \
    const int gw = bx * NWAVES + wave, ngw = G * NWAVES, gtid = bx * NT + tid, gthreads = G * NT; (void)lane; (void)gw; (void)ngw; (void)gtid; (void)gthreads;
    const int G = gridDim.x, bx = blockIdx.x;
    unsigned char* ws = args.ws;
    const float* x = args.in[0]; float* out = args.out;
    bf16* Wgu = (bf16*)(ws + WS_WGU); bf16* Wd = (bf16*)(ws + WS_WD); bf16* Win = (bf16*)(ws + WS_WIN); bf16* Wglr = (bf16*)(ws + WS_WGLR);
    bf16* Woc = (bf16*)(ws + WS_WOC); bf16* Wog = (bf16*)(ws + WS_WOG); bf16* Wo = (bf16*)(ws + WS_WO);
    bf16* H = (bf16*)(ws + WS_H); bf16* ACT = (bf16*)(ws + WS_ACT);
    float* GLR = (float*)(ws + WS_GLR);
    const int lo = args.ph_lo, hi = args.ph_hi;
    if (lo < 0) cg::this_grid().sync();
    volatile LAS unsigned* xst = (volatile LAS unsigned*)(lds + 131072 + 512);
    if (threadIdx.x < 2) xst[threadIdx.x] = 0u;
    __syncthreads();
    XcdBarrier xbar; xbar.bar = (unsigned*)(ws + WS_CTL) + 1024; xbar.x = 0; xbar.st = xst;
    if (!MK_SPLIT) xbar = xcd_barrier_post((unsigned*)(ws + WS_CTL) + 1024, xst);
#define IN(k) (lo <= (k) && (k) < hi)
#ifndef REP_PHASE
#define REP_PHASE -1
#endif
#define REPS(k) for (int rep_ = 0; rep_ < ((k) == REP_PHASE ? 2 : 1); ++rep_)
#if MK_SPLIT
#define SEAM(k) do { } while (0)
#else
#define SEAM(k) do { if (IN(k) && IN((k) + 1)) xcd_barrier(xbar); } while (0)
#endif
#define RTAB ((const LAS float*)(lds + 131072 + 1024))
#define FILL_RTAB(Nn, SSp) do { pg8::StaticOrder S_; S_.init(M, (Nn), G, bx); pg8::Unit u_; \
        for (int i_ = threadIdx.x; i_ < 8 * 256; i_ += NT) { if (S_.next(i_ >> 8, u_)) ((LAS float*)(lds + 131072 + 1024))[i_] = pg8::row_rinv((SSp), u_.pm * 256 + (i_ & 255)); } \
        __syncthreads(); } while (0)
#define RUN_GEMM(EPI, Ap, Bp, Nn, Kk, Eobj) do { pg8::Gemm g_{(const pg8::bf16_t*)(Ap), (const pg8::bf16_t*)(Bp), M, (Nn), (Kk)}; pg8::StaticOrder S_; S_.init(M, (Nn), G, bx); \
        pg8::gemm_phase<EPI, pg8::StaticOrder, true, true>(lds, g_, S_, Eobj); } while (0)

    float* SS1 = (float*)(ws + WS_SS1); float* SS2 = (float*)(ws + WS_SS2); float* SS3 = (float*)(ws + WS_SS3); float* SS4 = (float*)(ws + WS_SS4);
    bf16* HB3 = (bf16*)(ws + WS_HB3);
    if (IN(0)) { FRESH_TID()
        LAS bf16* scr = (LAS bf16*)(lds + wave * 8192);
        tr_matrix<1>(args.in[2], 2 * FF, D, 2 * FF, Wgu, scr, gw, ngw, lane, args.in[1]);
        for (int m = gw; m < M; m += ngw) cvt_row_bf16(x + (size_t)m * D, H + (size_t)m * D, SS1 + (size_t)m * 16, lane);
    }
    SEAM(0);
    if (IN(1)) {
        { pg8::StaticOrder S_; S_.init(M, 2 * FF, G, bx); pg8::Unit u_; const int full = (M / 256) * (2 * FF / 256) / G;
          const int nidle = G - ((M / 256) * (2 * FF / 256) - full * G);
          if (!S_.next(full, u_) && nidle > 0) { FRESH_TID() const int iw = (bx - (G - nidle)) * NWAVES + wave, niw = nidle * NWAVES; LAS bf16* scr = (LAS bf16*)(lds + wave * 8192);
              tr_matrix<0>(args.in[3], D, FF, D, Wd, scr, iw, niw, lane, nullptr);
              tr_matrix<2>(args.in[5], INC, D, 8192, Win, scr, iw, niw, lane, args.in[4]);
              tr_matrix<0>(args.in[10], D, D, D, Woc, scr, iw, niw, lane, nullptr);
              tr_matrix<0>(args.in[11], D, D, D, Wog, scr, iw, niw, lane, nullptr);
              tr_matrix<0>(args.in[12], D, D, D, Wo, scr, iw, niw, lane, nullptr);
              tr_matrix<1>(args.in[14], 2 * FF, D, 2 * FF, (bf16*)(ws + WS_WGU2), scr, iw, niw, lane, args.in[13]);
              tr_matrix<0>(args.in[15], D, FF, D, (bf16*)(ws + WS_WD2), scr, iw, niw, lane, nullptr);
              for (int e = iw * 64 + lane; e < 16 * D; e += niw * 64) { const int nn = e >> 10, k = e & 1023; Wglr[e] = (bf16)(cvt_pk_bf16(args.in[5][(size_t)k * INC + 5120 + nn] * args.in[4][k], 0.f) & 0xffffu); }
              __syncthreads(); } }
        FILL_RTAB(2 * FF, SS1); pg8::EpiSwiglu E{(pg8::bf16_t*)ACT, FF, RTAB}; RUN_GEMM(pg8::EpiSwiglu, H, Wgu, 2 * FF, D, E); }
    if (REP_PHASE == 1 && IN(1)) { FILL_RTAB(2 * FF, SS1); pg8::EpiSwiglu E{(pg8::bf16_t*)ACT, FF, RTAB}; RUN_GEMM(pg8::EpiSwiglu, H, Wgu, 2 * FF, D, E); }
    SEAM(1);
    if (IN(2)) { pg8::EpiRes<true> E{x, out, D, 0.5f, (pg8::bf16_t*)H, SS2}; RUN_GEMM(pg8::EpiRes<true>, ACT, Wd, D, FF, E); }
    if (REP_PHASE == 2 && IN(2)) { pg8::EpiRes<true> E{x, out, D, 0.5f, (pg8::bf16_t*)H, SS2}; RUN_GEMM(pg8::EpiRes<true>, ACT, Wd, D, FF, E); }
    SEAM(2);
    if (IN(3)) { { FRESH_TID() for (int r = bx * 4 + wave; wave < 4 && r < M / 16; r += G * 4) glr_16(H, Wglr, SS2, GLR, r * 16, lane); }
        pg8::EpiZa E{(pg8::bf16_t*)(ws + WS_Q), (pg8::bf16_t*)(ws + WS_K), (pg8::bf16_t*)(ws + WS_V), (pg8::bf16_t*)(ws + WS_R), RTAB}; FILL_RTAB(3072, SS2); RUN_GEMM(pg8::EpiZa, H, Win, 3072, D, E); }
    SEAM(3);
    GlaPtrs GP{GLR, args.in[7], args.in[8], args.in[9], (const bf16*)(ws + WS_Q), (const bf16*)(ws + WS_K), (const bf16*)(ws + WS_V), (bf16*)(ws + WS_R), (bf16*)(ws + WS_KV), (float*)(ws + WS_DEC)};
    if (IN(4)) { FRESH_TID() for (int it = bx; it < NITEM; it += G) gla_a_item(lds, GP, it, tid); }
    SEAM(4);
    if (IN(5)) { FRESH_TID() gla_scan((bf16*)(ws + WS_KV), (const float*)(ws + WS_DEC), gtid, gthreads); }
    SEAM(5);
    if (IN(6)) { FRESH_TID() for (int it = bx; it < NITEM; it += G) gla_c_item(lds, GP, it, tid); }
    SEAM(6);
    if (IN(7)) { pg8::EpiZb E{(pg8::bf16_t*)(ws + WS_CB), (pg8::bf16_t*)(ws + WS_P), (pg8::bf16_t*)(ws + WS_GA), (pg8::bf16_t*)(ws + WS_GB), RTAB}; FILL_RTAB(5120, SS2); RUN_GEMM(pg8::EpiZb, H, Win + (size_t)3072 * D, 5120, D, E); }
    SEAM(7);
    if (IN(8)) { FRESH_TID() conv_pass((bf16*)(ws + WS_CB), (const bf16*)(ws + WS_P), args.in[6], gtid, gthreads); }
    SEAM(8);
    if (IN(9)) {
        { pg8::EpiGate<0> E{(const pg8::bf16_t*)(ws + WS_GA), nullptr, (pg8::bf16_t*)(ws + WS_P)}; RUN_GEMM(pg8::EpiGate<0>, ws + WS_CB, Woc, D, D, E); }
        { pg8::EpiGate<1> E{(const pg8::bf16_t*)(ws + WS_GB), (const pg8::bf16_t*)(ws + WS_P), (pg8::bf16_t*)(ws + WS_H)}; RUN_GEMM(pg8::EpiGate<1>, ws + WS_R, Wog, D, D, E); }
    }
    if (REP_PHASE == 9 && IN(9)) {
        { pg8::EpiGate<0> E{(const pg8::bf16_t*)(ws + WS_GA), nullptr, (pg8::bf16_t*)(ws + WS_P)}; RUN_GEMM(pg8::EpiGate<0>, ws + WS_CB, Woc, D, D, E); }
        { pg8::EpiGate<1> E{(const pg8::bf16_t*)(ws + WS_GB), (const pg8::bf16_t*)(ws + WS_P), (pg8::bf16_t*)(ws + WS_H)}; RUN_GEMM(pg8::EpiGate<1>, ws + WS_R, Wog, D, D, E); }
    }
    SEAM(9);
    if (IN(10)) { pg8::EpiRes<true> E{out, out, D, 1.0f, (pg8::bf16_t*)HB3, SS3}; RUN_GEMM(pg8::EpiRes<true>, H, Wo, D, D, E); }
    SEAM(10);
    if (IN(11)) { FILL_RTAB(2 * FF, SS3); pg8::EpiSwiglu E{(pg8::bf16_t*)ACT, FF, RTAB}; RUN_GEMM(pg8::EpiSwiglu, HB3, ws + WS_WGU2, 2 * FF, D, E); }
    SEAM(11);
    if (IN(12)) { pg8::EpiRes<false> E{out, out, D, 0.5f, nullptr, SS4}; RUN_GEMM(pg8::EpiRes<false>, ACT, ws + WS_WD2, D, FF, E); }
    SEAM(12);
    if (IN(13)) { FRESH_TID() const float* gf = args.in[16];
        for (int e = gtid; e < M * 256; e += gthreads) { const int row = e >> 8, c4 = (e & 255) * 4; const float ri = pg8::row_rinv(SS4, row);
            f32x4* p = (f32x4*)(out + (size_t)row * D + c4); *p = *p * ri * *(const f32x4*)(gf + c4); } }
}

extern "C" void kernel_launch(void* const* d_in, const int* in_sizes, int n_in, void* d_out, int out_size, void* d_ws, size_t ws_size, hipStream_t stream) {
    static int grid = 0;
    if (grid == 0) {
        if (n_in != 17 || in_sizes[0] != M * D || out_size != M * D || ws_size < WS_END) { fprintf(stderr, "kernel_launch: unexpected shapes / workspace (n_in %d, ws %zu)\n", n_in, ws_size); grid = -1; return; }
        int dev = 0, cus = 0, per_cu = 0;
        hipGetDevice(&dev); hipDeviceGetAttribute(&cus, hipDeviceAttributeMultiprocessorCount, dev);
        if (hipFuncSetAttribute((const void*)mega_fwd, hipFuncAttributeMaxDynamicSharedMemorySize, LDS_BYTES) != hipSuccess) { fprintf(stderr, "kernel_launch: hipFuncSetAttribute failed\n"); grid = -1; return; }
        if (hipOccupancyMaxActiveBlocksPerMultiprocessor(&per_cu, (const void*)mega_fwd, NT, LDS_BYTES) != hipSuccess || per_cu < 1) { per_cu = 1; (void)hipGetLastError(); }
        grid = cus * per_cu;
    }
    if (grid < 0) return;
    if (hipMemsetAsync((char*)d_ws + WS_CTL, 0, CTL_ZERO_BYTES, stream) != hipSuccess) { fprintf(stderr, "kernel_launch: memset failed\n"); return; }
    Args a{};
    for (int i = 0; i < 17; ++i) a.in[i] = (const float*)d_in[i];
    a.out = (float*)d_out; a.ws = (unsigned char*)d_ws;
#if MK_SPLIT
    for (int p = 0; p < NPHASE; ++p) { a.ph_lo = p; a.ph_hi = p + 1; hipLaunchKernelGGL(mega_fwd, dim3(grid), dim3(NT), LDS_BYTES, stream, a); }
#else
    a.ph_lo = 0; a.ph_hi = NPHASE;
    void* kargs[] = {&a};
    hipError_t e = hipLaunchCooperativeKernel((const void*)mega_fwd, dim3(grid), dim3(NT), kargs, LDS_BYTES, stream);
    if (e != hipSuccess) fprintf(stderr, "cooperative launch failed: %s (grid %d)\n", hipGetErrorString(e), grid);
#endif
}
```
